# Optimizing an MI355X kernel written in HIP

```python
import math
import jax, jax.numpy as jnp
from jax import lax
import numpy as np

D_MODEL = 2048
BATCH = 4
SEQ = 4096
DEPTH = 2

N_META = 16
BLOCK = 128
WINDOW = 128
META_PAD = BLOCK - N_META
HEAD_DIM = 64
N_Q_HEADS = 16
N_KV_HEADS = 4
Q_PER_KV = N_Q_HEADS // N_KV_HEADS
ATTN_WIDTH = N_Q_HEADS * HEAD_DIM
KV_WIDTH = N_KV_HEADS * HEAD_DIM
SSM_WIDTH = D_MODEL // 2
SSM_GROUP = 16
SSM_GROUPS = SSM_WIDTH // SSM_GROUP
SSM_STATE = 64
DT_MIN = 1e-3
DT_MAX = 1e-1
D_FF = 4 * D_MODEL
N_BUCKETS = 32
MAX_DISTANCE = 128
DN_ALPHA = (2 * DEPTH) ** 0.25
DN_BETA = (8 * DEPTH) ** -0.25
LN_EPS = 1e-5
NEG_INF = -1e30
IN_WIDTH = ATTN_WIDTH + 2 * KV_WIDTH + SSM_WIDTH + 2 * D_MODEL
SPLITS = [ATTN_WIDTH, ATTN_WIDTH + KV_WIDTH, ATTN_WIDTH + 2 * KV_WIDTH,
          ATTN_WIDTH + 2 * KV_WIDTH + SSM_WIDTH]

kernel_name = 'hybrid_s5_swa_gated_deepnorm'


def layer_norm(x, g, b):
    xf = x.astype(jnp.float32)
    mu = jnp.mean(xf, axis=-1, keepdims=True)
    xc = xf - mu
    var = jnp.mean(xc * xc, axis=-1, keepdims=True)
    y = xc * lax.rsqrt(var + LN_EPS) * g.astype(jnp.float32) + b.astype(jnp.float32)
    return y.astype(x.dtype)


def t5_bucket(dist):
    n = jnp.maximum(dist, 0)
    max_exact = N_BUCKETS // 2
    nf = jnp.maximum(n, 1).astype(jnp.float32)
    large = max_exact + (jnp.log(nf / max_exact) / math.log(MAX_DISTANCE / max_exact)
                         * (N_BUCKETS - max_exact)).astype(jnp.int32)
    large = jnp.minimum(large, N_BUCKETS - 1)
    return jnp.where(n < max_exact, n, large)


def band_layout(n_blocks):
    blk = jnp.arange(n_blocks, dtype=jnp.int32)[:, None]
    j = jnp.arange(BLOCK, dtype=jnp.int32)[None, :]
    q_pos = blk * BLOCK + j
    k_meta = jnp.broadcast_to(j, (n_blocks, BLOCK))
    k_prev = (blk - 1) * BLOCK + j
    k_pos = jnp.concatenate([k_meta, k_prev, q_pos], axis=1)
    dist = q_pos[:, :, None] - k_pos[:, None, :]
    kp = k_pos[:, None, :]
    is_meta_seg = (jnp.arange(3 * BLOCK) < BLOCK)[None, None, :]
    meta_ok = kp >= META_PAD
    real_ok = (kp >= BLOCK) & (dist < WINDOW)
    valid = (dist >= 0) & jnp.where(is_meta_seg, meta_ok, real_ok)
    return dist, valid


def sliding_window_attention(q, k, v, attn_bias, sinks):
    b, lp, _ = q.shape
    nb = lp // BLOCK
    q = q.reshape(b, nb, BLOCK, N_KV_HEADS, Q_PER_KV, HEAD_DIM)

    def bands(t):
        t = t.reshape(b, nb, BLOCK, N_KV_HEADS, HEAD_DIM)
        meta = jnp.broadcast_to(t[:, :1], t.shape)
        prev = jnp.pad(t[:, :-1], ((0, 0), (1, 0), (0, 0), (0, 0), (0, 0)))
        return jnp.concatenate([meta, prev, t], axis=2)

    kb, vb = bands(k), bands(v)
    s = jnp.einsum('bnqkgd,bnskd->bnkgqs', q, kb).astype(jnp.float32) * (HEAD_DIM ** -0.5) + attn_bias
    sink = sinks.astype(jnp.float32).reshape(1, 1, N_KV_HEADS, Q_PER_KV, 1, 1)
    m = jnp.maximum(jnp.max(s, axis=-1, keepdims=True), sink)
    p = jnp.exp(s - m)
    p = p / (jnp.sum(p, axis=-1, keepdims=True) + jnp.exp(sink - m))
    o = jnp.einsum('bnkgqs,bnskd->bnqkgd', p.astype(vb.dtype), vb)
    return o.reshape(b, lp, ATTN_WIDTH)


def s5_mixer(u, lam_re, lam_im, log_step, b_re, b_im, c_re, c_im, d_skip, w_glu):
    bsz, L, _ = u.shape
    uf = u.astype(jnp.float32).reshape(bsz, L, SSM_GROUPS, SSM_GROUP)
    lr, li = lam_re.astype(jnp.float32), lam_im.astype(jnp.float32)
    dt = jnp.exp(log_step.astype(jnp.float32))[:, None]
    decay = jnp.exp(lr * dt)
    ar, ai = decay * jnp.cos(li * dt), decay * jnp.sin(li * dt)
    den = lr * lr + li * li
    nr, ni = ar - 1.0, ai
    zr = (nr * lr + ni * li) / den
    zi = (ni * lr - nr * li) / den
    br_, bi_ = b_re.astype(jnp.float32), b_im.astype(jnp.float32)
    bbar_re = zr[..., None] * br_ - zi[..., None] * bi_
    bbar_im = zr[..., None] * bi_ + zi[..., None] * br_
    xr = jnp.einsum('blgp,gnp->blgn', uf, bbar_re)
    xi = jnp.einsum('blgp,gnp->blgn', uf, bbar_im)
    a_r = jnp.broadcast_to(ar, (1, L) + ar.shape)
    a_i = jnp.broadcast_to(ai, (1, L) + ai.shape)

    def combine(e1, e2):
        a1r, a1i, b1r, b1i = e1
        a2r, a2i, b2r, b2i = e2
        return (a1r * a2r - a1i * a2i,
                a1r * a2i + a1i * a2r,
                a2r * b1r - a2i * b1i + b2r,
                a2r * b1i + a2i * b1r + b2i)

    _, _, hr, hi = lax.associative_scan(combine, (a_r, a_i, xr, xi), axis=1)
    y = (jnp.einsum('blgn,gpn->blgp', hr, c_re.astype(jnp.float32))
         - jnp.einsum('blgn,gpn->blgp', hi, c_im.astype(jnp.float32))
         + d_skip.astype(jnp.float32) * uf)
    y = jax.nn.gelu(y.reshape(bsz, L, SSM_WIDTH))
    y = y * jax.nn.sigmoid(y @ w_glu.astype(jnp.float32))
    return y.astype(u.dtype)


def hybrid_layer(h, attn_bias, in_proj, gate_b, sinks, lam_re, lam_im, log_step, b_re, b_im,
                 c_re, c_im, d_skip, w_glu, w_attn_up, w_ssm_up, w_out, ln_mix_g, ln_mix_b,
                 w_mlp_up, w_mlp_down, ln_mlp_g, ln_mlp_b):
    z = h @ in_proj
    q, k, v, u, g = jnp.split(z, SPLITS, axis=-1)
    gates = jax.nn.sigmoid((g + gate_b).astype(jnp.float32)).astype(h.dtype)
    g_attn, g_ssm = jnp.split(gates, 2, axis=-1)
    pad = ((0, 0), (META_PAD, 0), (0, 0))
    y_attn = sliding_window_attention(jnp.pad(q, pad), jnp.pad(k, pad), jnp.pad(v, pad),
                                      attn_bias, sinks)[:, META_PAD:]
    y_ssm = s5_mixer(u, lam_re, lam_im, log_step, b_re, b_im, c_re, c_im, d_skip, w_glu)
    mixed = (g_attn * (y_attn @ w_attn_up) + g_ssm * (y_ssm @ w_ssm_up)) @ w_out
    h = layer_norm(DN_ALPHA * h + mixed, ln_mix_g, ln_mix_b)
    f = jnp.square(jax.nn.relu(h @ w_mlp_up)) @ w_mlp_down
    return layer_norm(DN_ALPHA * h + f, ln_mlp_g, ln_mlp_b)


def setup_inputs(seed: int = 0) -> dict:
    key = jax.random.key(seed)
    ks = jax.random.split(key, 32)
    f32 = jnp.float32

    def nrm(k, shape, scale):
        return jax.random.normal(k, shape, f32) * scale

    G, N, P = SSM_GROUPS, SSM_STATE, SSM_GROUP
    n_idx = jnp.arange(N, dtype=f32)
    return {
        'x': nrm(ks[0], (BATCH, SEQ, D_MODEL), 1.0),
        'meta_tokens': nrm(ks[1], (N_META, D_MODEL), 1.0),
        'ln_emb_g': 1.0 + nrm(ks[2], (D_MODEL,), 0.02),
        'ln_emb_b': nrm(ks[3], (D_MODEL,), 0.02),
        'rel_bias': nrm(ks[4], (N_BUCKETS, N_Q_HEADS), 0.5),
        'in_proj': nrm(ks[5], (DEPTH, D_MODEL, IN_WIDTH), D_MODEL ** -0.5),
        'gate_b': nrm(ks[6], (DEPTH, 2 * D_MODEL), 0.02),
        'attn_sinks': nrm(ks[7], (DEPTH, N_Q_HEADS), 0.5),
        'ssm_lambda_re': -0.5 + nrm(ks[8], (DEPTH, G, N), 0.01),
        'ssm_lambda_im': math.pi * n_idx + nrm(ks[9], (DEPTH, G, N), 0.01),
        'ssm_log_step': jax.random.uniform(ks[10], (DEPTH, G), f32, math.log(DT_MIN), math.log(DT_MAX)),
        'ssm_b_re': nrm(ks[11], (DEPTH, G, N, P), (2 * P) ** -0.5),
        'ssm_b_im': nrm(ks[12], (DEPTH, G, N, P), (2 * P) ** -0.5),
        'ssm_c_re': nrm(ks[13], (DEPTH, G, P, N), 0.5 ** 0.5),
        'ssm_c_im': nrm(ks[14], (DEPTH, G, P, N), 0.5 ** 0.5),
        'ssm_d': nrm(ks[15], (DEPTH, G, P), 0.5),
        'ssm_w_glu': nrm(ks[16], (DEPTH, SSM_WIDTH, SSM_WIDTH), SSM_WIDTH ** -0.5),
        'w_attn_up': nrm(ks[17], (DEPTH, ATTN_WIDTH, D_MODEL), ATTN_WIDTH ** -0.5),
        'w_ssm_up': nrm(ks[18], (DEPTH, SSM_WIDTH, D_MODEL), SSM_WIDTH ** -0.5),
        'w_out': nrm(ks[19], (DEPTH, D_MODEL, D_MODEL), DN_BETA * D_MODEL ** -0.5),
        'ln_mix_g': 1.0 + nrm(ks[20], (DEPTH, D_MODEL), 0.02),
        'ln_mix_b': nrm(ks[21], (DEPTH, D_MODEL), 0.02),
        'w_mlp_up': nrm(ks[22], (DEPTH, D_MODEL, D_FF), D_MODEL ** -0.5),
        'w_mlp_down': nrm(ks[23], (DEPTH, D_FF, D_MODEL), DN_BETA * D_FF ** -0.5),
        'ln_mlp_g': 1.0 + nrm(ks[24], (DEPTH, D_MODEL), 0.02),
        'ln_mlp_b': nrm(ks[25], (DEPTH, D_MODEL), 0.02),
    }


def reference(x, meta_tokens, ln_emb_g, ln_emb_b, rel_bias, in_proj, gate_b, attn_sinks,
              ssm_lambda_re, ssm_lambda_im, ssm_log_step, ssm_b_re, ssm_b_im, ssm_c_re, ssm_c_im,
              ssm_d, ssm_w_glu, w_attn_up, w_ssm_up, w_out, ln_mix_g, ln_mix_b,
              w_mlp_up, w_mlp_down, ln_mlp_g, ln_mlp_b):
    bsz, seq, _ = x.shape
    meta = jnp.broadcast_to(meta_tokens[None].astype(x.dtype), (bsz, N_META, D_MODEL))
    h = layer_norm(jnp.concatenate([meta, x], axis=1), ln_emb_g, ln_emb_b)

    n_blocks = (seq + BLOCK) // BLOCK
    dist, valid = band_layout(n_blocks)
    bias = rel_bias.astype(jnp.float32)[t5_bucket(dist)]
    bias = bias.transpose(0, 3, 1, 2).reshape(n_blocks, N_KV_HEADS, Q_PER_KV, BLOCK, 3 * BLOCK)
    attn_bias = jnp.where(valid[:, None, None], bias, NEG_INF)

    for l in range(DEPTH):
        h = hybrid_layer(h, attn_bias, in_proj[l], gate_b[l], attn_sinks[l],
                         ssm_lambda_re[l], ssm_lambda_im[l], ssm_log_step[l],
                         ssm_b_re[l], ssm_b_im[l], ssm_c_re[l], ssm_c_im[l], ssm_d[l],
                         ssm_w_glu[l], w_attn_up[l], w_ssm_up[l], w_out[l],
                         ln_mix_g[l], ln_mix_b[l], w_mlp_up[l], w_mlp_down[l],
                         ln_mlp_g[l], ln_mlp_b[l])
    return h[:, N_META:]
```

```cpp
#include <hip/hip_runtime.h>
#include <hip/hip_cooperative_groups.h>
#include <cstdio>
namespace cg = cooperative_groups;

#define LAS __attribute__((address_space(3)))
typedef unsigned short bf16_t;
typedef short bf16x8 __attribute__((ext_vector_type(8)));
typedef float f32x4 __attribute__((ext_vector_type(4)));
typedef float f32x2 __attribute__((ext_vector_type(2)));
typedef unsigned u32x4 __attribute__((ext_vector_type(4)));
typedef unsigned u32x2 __attribute__((ext_vector_type(2)));

constexpr int D = 2048, NB = 4, SEQ = 4096, NMETA = 16;
constexpr int MSEQ = NB * SEQ;
constexpr int MROWS = MSEQ + NB * NMETA;
constexpr int MPAD = 16640;
constexpr int INW = 6656, DFF = 8192, AW = 1024, KVW = 256, SW = 1024;
constexpr float DN_ALPHA = 1.41421356237f;
constexpr float LOG2E = 1.44269504089f;

constexpr size_t OFF_H32 = 0;
constexpr size_t SZ_H32 = (size_t)MPAD * D * 4;
constexpr size_t OFF_HB = OFF_H32 + SZ_H32;
constexpr size_t SZ_HB = (size_t)MPAD * D * 2;
constexpr size_t OFF_POOL = OFF_HB + SZ_HB;
constexpr size_t SZ_POOL = (size_t)MPAD * DFF * 2;
constexpr size_t PO_Q = 0;
constexpr size_t PO_K = PO_Q + (size_t)MPAD * AW * 2;
constexpr size_t PO_V = PO_K + (size_t)MPAD * KVW * 2;
constexpr size_t PO_U = PO_V + (size_t)MPAD * KVW * 2;
constexpr size_t PO_G = PO_U + (size_t)MPAD * SW * 2;
constexpr size_t PO_YA = PO_G + (size_t)MPAD * 4096 * 2;
static_assert(PO_YA + (size_t)MPAD * AW * 2 <= SZ_POOL, "pool");
constexpr size_t OFF_WT = OFF_POOL + SZ_POOL;
constexpr size_t SZ_WT = (size_t)2 * D * DFF * 2;
constexpr size_t WA_IN = 0;
constexpr size_t WA_GLU = WA_IN + (size_t)INW * D * 2;
constexpr size_t WA_AU = WA_GLU + (size_t)SW * SW * 2;
constexpr size_t WA_SU = WA_AU + (size_t)AW * D * 2;
constexpr size_t WA_OUT = WA_SU + (size_t)SW * D * 2;
static_assert(WA_OUT + (size_t)D * D * 2 <= SZ_WT, "wt");
constexpr size_t WB_UP = 0;
constexpr size_t WB_DN = (size_t)D * DFF * 2;
constexpr size_t OFF_SC = OFF_WT + SZ_WT;
constexpr size_t SZ_SC = (size_t)NB * 64 * 32 * 64 * 8;
constexpr size_t WS_END = OFF_SC + SZ_SC;

constexpr int LDS_BYTES = 140864;
#ifndef ONLY
#define ONLY -1
#endif
#ifndef MASK
#define MASK 0xFFFF
#endif
#define EN(k) (((MASK) >> (k)) & 1)

struct Args { const float* in[26]; float* out; unsigned char* ws; int ph_lo, ph_hi; };

__device__ __forceinline__ unsigned cvt_pk_bf16(float lo, float hi) { unsigned r; asm volatile("v_cvt_pk_bf16_f32 %0, %1, %2" : "=v"(r) : "v"(lo), "v"(hi)); return r; }
__device__ __forceinline__ float bflo(unsigned w) { return __uint_as_float(w << 16); }
__device__ __forceinline__ float bfhi(unsigned w) { return __uint_as_float(w & 0xffff0000u); }
__device__ __forceinline__ float bf2f(bf16_t v) { return __uint_as_float(((unsigned)v) << 16); }
__device__ __forceinline__ float sigmoid_f(float x) { return __builtin_amdgcn_rcpf(1.0f + __builtin_amdgcn_exp2f(-x * LOG2E)); }
template <int CTRL> __device__ __forceinline__ float dpp_f(float v) { return __int_as_float(__builtin_amdgcn_update_dpp(0, __float_as_int(v), CTRL, 0xf, 0xf, true)); }
__device__ __forceinline__ float row16_max(float v) { v = fmaxf(v, dpp_f<0xB1>(v)); v = fmaxf(v, dpp_f<0x4E>(v)); v = fmaxf(v, dpp_f<0x141>(v)); v = fmaxf(v, dpp_f<0x140>(v)); return v; }
__device__ __forceinline__ float row16_sum(float v) { v += dpp_f<0xB1>(v); v += dpp_f<0x4E>(v); v += dpp_f<0x141>(v); v += dpp_f<0x140>(v); return v; }
__device__ __forceinline__ float wave_sum(float v) { for (int o = 32; o > 0; o >>= 1) v += __shfl_xor(v, o); return v; }
__device__ __forceinline__ int t5_bucket(int n) {
    if (n < 16) return n;
    return 16 + (n >= 19) + (n >= 21) + (n >= 24) + (n >= 27) + (n >= 31) + (n >= 35) + (n >= 40) + (n >= 46) + (n >= 52) + (n >= 59) + (n >= 67) + (n >= 77) + (n >= 87) + (n >= 99) + (n >= 113);
}

namespace pg8 {
constexpr int BM = 256, BK = 64, HALF = 128, HTB = HALF * BK * 2, STAGE_BYTES = 8 * HTB, NXCD = 8, WGM = 8;
__device__ __forceinline__ int lds_byte(int r, int c) { const int st = (r >> 4) * 2 + (c >> 5), rr = r & 15, cc = c & 31, ob = rr * 64 + cc * 2; return st * 1024 + (ob ^ (((ob >> 9) & 1) << 5)); }
__device__ __forceinline__ void stage_rc(int b, int& R, int& C) { const int st = b / 1024, sb = b % 1024, swz = sb ^ (((sb >> 9) & 1) << 5); R = (st >> 1) * 16 + swz / 64; C = (st & 1) * 32 + (swz % 64) / 2; }
__device__ __forceinline__ int perm32(int rho) { const int n = rho >> 4, i = rho & 15; return 8 * (i >> 2) + 4 * n + (i & 3); }
struct Unit { int pm, pn; };
struct Gemm { const bf16_t* A; const bf16_t* Bt; int M, N, K; };
struct StaticOrder {
    int nM, nN, nwg, G, c;
    __device__ void init(int M, int N, int G_, int c_) { nM = M / BM; nN = N / BM; nwg = nM * nN; G = G_; c = c_; }
    __device__ bool next(int i, Unit& u) const {
        const long L = (long)i * G + c; if (L >= nwg) return false;
        int wgid = (int)L; { const int q = nwg / NXCD, r = nwg % NXCD, xcd = wgid % NXCD, off = wgid / NXCD; wgid = (xcd < r ? xcd * (q + 1) : r * (q + 1) + (xcd - r) * q) + off; }
        const int nig = WGM * nN, gid = wgid / nig, fm = gid * WGM, gsz = (nM - fm) < WGM ? (nM - fm) : WGM;
        u.pm = fm + ((wgid % nig) % gsz); u.pn = (wgid % nig) / gsz; return true;
    }
};
template <class Epi>
__device__ __forceinline__ void gemm_phase(LAS unsigned char* lds, const Gemm g, const StaticOrder& S, const Epi& E, const int tid) {
    const int wid = __builtin_amdgcn_readfirstlane(tid >> 6), lane = tid & 63, wr = wid >> 2, wc = wid & 3, fr = lane & 15, fq = lane >> 4;
    const int K = g.K, nt = K / BK;
    unsigned voffA[2], voffB[2];
#pragma unroll
    for (int i = 0; i < 2; ++i) { int R, C; stage_rc(tid * 16 + i * 8192, R, C); const int Rb = E.perm() ? ((R & ~31) + perm32(R & 31)) : R;
        voffA[i] = (unsigned)(R * K + C) * 2u; voffB[i] = (unsigned)(Rb * K + C) * 2u; }
    const size_t kstep = (size_t)(BK * 2);
    const size_t hstep = (size_t)HALF * K * 2;
    const size_t tstep = 2 * hstep;
    const unsigned ldsw = (unsigned)wid * 1024u;
    const int aoff = lds_byte(wr * 64 + fr, fq * 8), boff = lds_byte(wc * 32 + fr, fq * 8);
#define PG8_SA(b, h) (((b) * 2 + (h)) * HTB)
#define PG8_SB(b, h) ((4 + (b) * 2 + (h)) * HTB)
#define PG8_STAGE(bufoff, gbase, voff) do { _Pragma("unroll") for (int _i = 0; _i < 2; ++_i) \
        __builtin_amdgcn_global_load_lds((const unsigned*)((const char*)(gbase) + (voff)[_i]), (LAS unsigned*)(lds + (bufoff) + ldsw + _i * 8192), 16, 0, 0); } while (0)
#define PG8_LDA(dst, b, h) do { _Pragma("unroll") for (int m = 0; m < 4; ++m) _Pragma("unroll") for (int k = 0; k < 2; ++k) dst[m][k] = *(const LAS bf16x8*)(lds + PG8_SA(b, h) + aoff + m * 2048 + k * 1024); } while (0)
#define PG8_LDB(dst, b, h) do { _Pragma("unroll") for (int n = 0; n < 2; ++n) _Pragma("unroll") for (int k = 0; k < 2; ++k) dst[n][k] = *(const LAS bf16x8*)(lds + PG8_SB(b, h) + boff + n * 2048 + k * 1024); } while (0)
#define PG8_MMA(ai, bj, At, Bt) do { __builtin_amdgcn_s_setprio(1); _Pragma("unroll") for (int m = 0; m < 4; ++m) _Pragma("unroll") for (int n = 0; n < 2; ++n) _Pragma("unroll") for (int k = 0; k < 2; ++k) \
        acc[ai][bj][m][n] = __builtin_amdgcn_mfma_f32_16x16x32_bf16(Bt[n][k], At[m][k], acc[ai][bj][m][n], 0, 0, 0); __builtin_amdgcn_s_setprio(0); } while (0)
#define PG8_WAIT_V(n) asm volatile("s_waitcnt vmcnt(" #n ")" ::: "memory")
#define PG8_WAIT_L(n) asm volatile("s_waitcnt lgkmcnt(" #n ")" ::: "memory")
#define PG8_BAR __builtin_amdgcn_s_barrier()
#define PG8_SCHED __builtin_amdgcn_sched_barrier(0)
    Unit cur, nxt; int ui = 0;
    if (!S.next(0, cur)) return;
    f32x4 acc[2][2][4][2];
#pragma unroll
    for (int a = 0; a < 2; ++a)
#pragma unroll
        for (int b = 0; b < 2; ++b)
#pragma unroll
            for (int m = 0; m < 4; ++m)
#pragma unroll
                for (int n = 0; n < 2; ++n) acc[a][b][m][n] = (f32x4){0.f, 0.f, 0.f, 0.f};
    bf16x8 At[4][2], B0[2][2], B1[2][2];
    const char* cA = (const char*)g.A + (size_t)cur.pm * tstep; const char* cB = (const char*)g.Bt + (size_t)cur.pn * tstep;
    PG8_STAGE(PG8_SB(0, 0), cB, voffB); PG8_STAGE(PG8_SA(0, 0), cA, voffA); PG8_STAGE(PG8_SB(0, 1), cB + hstep, voffB); PG8_STAGE(PG8_SA(0, 1), cA + hstep, voffA);
    if (wr == 1) PG8_BAR;
    PG8_WAIT_V(4); PG8_BAR;
    PG8_STAGE(PG8_SB(1, 0), cB + kstep, voffB); PG8_STAGE(PG8_SA(1, 0), cA + kstep, voffA); PG8_STAGE(PG8_SB(1, 1), cB + hstep + kstep, voffB);
    PG8_WAIT_V(6); PG8_BAR;
    for (;;) {
        const bool has_next = S.next(ui + 1, nxt);
        const char* nA = has_next ? (const char*)g.A + (size_t)nxt.pm * tstep : cA; const char* nB = has_next ? (const char*)g.Bt + (size_t)nxt.pn * tstep : cB;
        for (int t = 0; t < nt; t += 2) {
            const bool last = (t == nt - 2);
            const char* a1 = cA + (size_t)(t + 1) * kstep;
            const char* a2 = last ? nA : cA + (size_t)(t + 2) * kstep; const char* b2 = last ? nB : cB + (size_t)(t + 2) * kstep;
            const char* a3 = a2 + kstep; const char* b3 = b2 + kstep;
            PG8_LDB(B0, 0, 0); PG8_SCHED; PG8_LDA(At, 0, 0); PG8_STAGE(PG8_SA(1, 1), a1 + hstep, voffA);
            PG8_WAIT_L(8); PG8_BAR; PG8_WAIT_L(0); PG8_MMA(0, 0, At, B0); PG8_BAR; PG8_SCHED;
            PG8_LDB(B1, 0, 1); PG8_STAGE(PG8_SB(0, 0), b2, voffB);
            PG8_BAR; PG8_WAIT_L(0); PG8_MMA(0, 1, At, B1); PG8_BAR;
            PG8_LDA(At, 0, 1); PG8_STAGE(PG8_SA(0, 0), a2, voffA);
            PG8_BAR; PG8_WAIT_L(0); PG8_MMA(1, 0, At, B0); PG8_BAR; PG8_SCHED;
            PG8_STAGE(PG8_SB(0, 1), b2 + hstep, voffB);
            PG8_WAIT_V(6); PG8_BAR; PG8_MMA(1, 1, At, B1); PG8_BAR;
            PG8_LDB(B0, 1, 0); PG8_SCHED; PG8_LDA(At, 1, 0); PG8_STAGE(PG8_SA(0, 1), a2 + hstep, voffA);
            PG8_WAIT_L(8); PG8_BAR; PG8_WAIT_L(0); PG8_MMA(0, 0, At, B0); PG8_BAR; PG8_SCHED;
            PG8_LDB(B1, 1, 1); PG8_STAGE(PG8_SB(1, 0), b3, voffB);
            PG8_BAR; PG8_WAIT_L(0); PG8_MMA(0, 1, At, B1); PG8_BAR;
            PG8_LDA(At, 1, 1); PG8_STAGE(PG8_SA(1, 0), a3, voffA);
            PG8_BAR; PG8_WAIT_L(0); PG8_MMA(1, 0, At, B0); PG8_BAR; PG8_SCHED;
            PG8_STAGE(PG8_SB(1, 1), b3 + hstep, voffB);
            PG8_WAIT_V(6); PG8_BAR; PG8_MMA(1, 1, At, B1); PG8_BAR;
        }
        E(acc, cur, wr, wc, fr, fq);
        if (!has_next) break;
#pragma unroll
        for (int a = 0; a < 2; ++a)
#pragma unroll
            for (int b = 0; b < 2; ++b)
#pragma unroll
                for (int m = 0; m < 4; ++m)
#pragma unroll
                    for (int n = 0; n < 2; ++n) acc[a][b][m][n] = (f32x4){0.f, 0.f, 0.f, 0.f};
        cur = nxt; cA = nA; cB = nB; ++ui;
    }
    PG8_WAIT_V(0);
    if (wr == 0) PG8_BAR;
    PG8_BAR;
#undef PG8_SA
#undef PG8_SB
#undef PG8_STAGE
#undef PG8_LDA
#undef PG8_LDB
#undef PG8_MMA
#undef PG8_WAIT_V
#undef PG8_WAIT_L
#undef PG8_BAR
#undef PG8_SCHED
}

typedef f32x4 Acc[2][2][4][2];
struct EpiAll {
    int mode;
    bf16_t* O; int ldc; const bf16_t* X; int ldx; float* H;
    bf16_t *Q, *Kb, *Vb, *U, *G; const float* gb;
    __device__ __forceinline__ bool perm() const { return mode != 5; }
    __device__ __forceinline__ void operator()(const Acc& acc, const Unit& u, int wr, int wc, int fr, int fq) const {
        if (mode == 5) {
            const int row0 = u.pm * BM + wr * 64 + fr, col0 = u.pn * BM + wc * 32 + 4 * fq;
#pragma unroll
            for (int ai = 0; ai < 2; ++ai)
#pragma unroll
                for (int m = 0; m < 4; ++m) { float* rowp = H + (size_t)(row0 + ai * HALF + m * 16) * D + col0;
#pragma unroll
                    for (int bj = 0; bj < 2; ++bj)
#pragma unroll
                        for (int n = 0; n < 2; ++n) { f32x4* p = (f32x4*)(rowp + bj * HALF + n * 16); const f32x4 h = *p; *p = h * DN_ALPHA + acc[ai][bj][m][n]; } }
            return;
        }
        bf16_t* base = O; int ld = ldc, colt = u.pn * BM; bool gate = false;
        if (mode == 0) { const int pn = u.pn;
            if (pn < 4) { base = Q; ld = AW; colt = pn * 256; }
            else if (pn == 4) { base = Kb; ld = KVW; colt = 0; }
            else if (pn == 5) { base = Vb; ld = KVW; colt = 0; }
            else if (pn < 10) { base = U; ld = SW; colt = (pn - 6) * 256; }
            else { base = G; ld = 4096; colt = (pn - 10) * 256; gate = true; } }
        const int row0 = u.pm * BM + wr * 64 + fr, col0 = colt + wc * 32 + 8 * fq;
        f32x4 bv[2][2];
#pragma unroll
        for (int bj = 0; bj < 2; ++bj)
#pragma unroll
            for (int n = 0; n < 2; ++n) bv[bj][n] = gate ? *(const f32x4*)(gb + col0 + bj * HALF + 4 * n) : (f32x4){0.f, 0.f, 0.f, 0.f};
#pragma unroll
        for (int ai = 0; ai < 2; ++ai)
#pragma unroll
            for (int m = 0; m < 4; ++m) { const size_t r = (size_t)(row0 + ai * HALF + m * 16);
#pragma unroll
                for (int bj = 0; bj < 2; ++bj) { f32x4 v0 = acc[ai][bj][m][0] + bv[bj][0], v1 = acc[ai][bj][m][1] + bv[bj][1];
                    bf16_t* op = base + r * ld + col0 + bj * HALF;
                    if (mode == 0) {
                        if (gate) {
#pragma unroll
                            for (int j = 0; j < 4; ++j) { v0[j] = sigmoid_f(v0[j]); v1[j] = sigmoid_f(v1[j]); } }
                    } else if (mode == 4) {
#pragma unroll
                        for (int j = 0; j < 4; ++j) { const float a0 = fmaxf(v0[j], 0.f), a1 = fmaxf(v1[j], 0.f); v0[j] = a0 * a0; v1[j] = a1 * a1; }
                    } else {
                        const u32x4 xw = *(const u32x4*)(X + r * ldx + col0 + bj * HALF);
                        const f32x4 x0 = {bflo(xw.x), bfhi(xw.x), bflo(xw.y), bfhi(xw.y)}, x1 = {bflo(xw.z), bfhi(xw.z), bflo(xw.w), bfhi(xw.w)};
                        if (mode == 1) {
#pragma unroll
                            for (int j = 0; j < 4; ++j) { v0[j] = x0[j] * sigmoid_f(v0[j]); v1[j] = x1[j] * sigmoid_f(v1[j]); }
                        } else { v0 = v0 * x0; v1 = v1 * x1;
                            if (mode == 3) { const u32x4 ow = *(const u32x4*)op;
                                const f32x4 o0 = {bflo(ow.x), bfhi(ow.x), bflo(ow.y), bfhi(ow.y)}, o1 = {bflo(ow.z), bfhi(ow.z), bflo(ow.w), bfhi(ow.w)};
                                v0 = v0 + o0; v1 = v1 + o1; } }
                    }
                    u32x4 w; w.x = cvt_pk_bf16(v0[0], v0[1]); w.y = cvt_pk_bf16(v0[2], v0[3]); w.z = cvt_pk_bf16(v1[0], v1[1]); w.w = cvt_pk_bf16(v1[2], v1[3]);
                    *(u32x4*)op = w; } }
    }
};
}

template <int MODE>
__device__ __forceinline__ void ln_phase(const float* x, const float* meta, const float* gam, const float* bet, float* H32, bf16_t* HB, float* out, int wave, int lane, int bid) {
    const int gw = bid * 8 + wave, nw = gridDim.x * 8;
    const int nrows = (MODE == 2) ? MSEQ : MPAD;
    for (int r = gw; r < nrows; r += nw) {
        const float* src;
        if (MODE == 0) src = (r < MSEQ) ? x + (size_t)r * D : (r < MROWS ? meta + (size_t)((r - MSEQ) & 15) * D : nullptr);
        else src = H32 + (size_t)r * D;
        f32x4 v[8];
        if (src) {
#pragma unroll
            for (int i = 0; i < 8; ++i) v[i] = *(const f32x4*)(src + i * 256 + lane * 4);
            float s = 0.f;
#pragma unroll
            for (int i = 0; i < 8; ++i) s += (v[i][0] + v[i][1]) + (v[i][2] + v[i][3]);
            const float mu = wave_sum(s) * (1.0f / D);
            float q = 0.f;
#pragma unroll
            for (int i = 0; i < 8; ++i) { v[i] = v[i] - mu; q += (v[i][0] * v[i][0] + v[i][1] * v[i][1]) + (v[i][2] * v[i][2] + v[i][3] * v[i][3]); }
            const float rstd = 1.0f / sqrtf(wave_sum(q) * (1.0f / D) + 1e-5f);
#pragma unroll
            for (int i = 0; i < 8; ++i) { const f32x4 g4 = *(const f32x4*)(gam + i * 256 + lane * 4), b4 = *(const f32x4*)(bet + i * 256 + lane * 4); v[i] = v[i] * rstd * g4 + b4; }
        } else {
#pragma unroll
            for (int i = 0; i < 8; ++i) v[i] = (f32x4){0.f, 0.f, 0.f, 0.f};
        }
        if (MODE == 2) {
#pragma unroll
            for (int i = 0; i < 8; ++i) *(f32x4*)(out + (size_t)r * D + i * 256 + lane * 4) = v[i];
        } else {
#pragma unroll
            for (int i = 0; i < 8; ++i) { *(f32x4*)(H32 + (size_t)r * D + i * 256 + lane * 4) = v[i];
                u32x2 w; w.x = cvt_pk_bf16(v[i][0], v[i][1]); w.y = cvt_pk_bf16(v[i][2], v[i][3]); *(u32x2*)(HB + (size_t)r * D + i * 256 + lane * 4) = w; }
        }
    }
}

__device__ __forceinline__ void convert_wt(const float* W, bf16_t* Wt, int K, int N, LAS unsigned char* lds, int tid, int bid) {
    LAS float* T = (LAS float*)lds;
    const int tn = N / 64, ntile = tn * (K / 64);
    for (int t = bid; t < ntile; t += gridDim.x) {
        const int k0 = (t / tn) * 64, n0 = (t % tn) * 64;
#pragma unroll
        for (int i = 0; i < 2; ++i) { const int idx = tid + i * 512, row = idx >> 4, c4 = idx & 15;
            const f32x4 v = *(const f32x4*)(W + (size_t)(k0 + row) * N + n0 + c4 * 4);
            T[row * 65 + c4 * 4 + 0] = v[0]; T[row * 65 + c4 * 4 + 1] = v[1]; T[row * 65 + c4 * 4 + 2] = v[2]; T[row * 65 + c4 * 4 + 3] = v[3]; }
        __syncthreads();
        { const int n = tid >> 3, k8 = tid & 7; float f[8];
#pragma unroll
            for (int e = 0; e < 8; ++e) f[e] = T[(k8 * 8 + e) * 65 + n];
            u32x4 w; w.x = cvt_pk_bf16(f[0], f[1]); w.y = cvt_pk_bf16(f[2], f[3]); w.z = cvt_pk_bf16(f[4], f[5]); w.w = cvt_pk_bf16(f[6], f[7]);
            *(u32x4*)(Wt + (size_t)(n0 + n) * K + k0 + k8 * 8) = w; }
        __syncthreads();
    }
}
__device__ __forceinline__ void convert_group_a(const Args& a, int l, unsigned char* wt, LAS unsigned char* lds, int tid, int bid) {
    convert_wt(a.in[5] + (size_t)l * D * INW, (bf16_t*)(wt + WA_IN), D, INW, lds, tid, bid);
    convert_wt(a.in[16] + (size_t)l * SW * SW, (bf16_t*)(wt + WA_GLU), SW, SW, lds, tid, bid);
    convert_wt(a.in[17] + (size_t)l * AW * D, (bf16_t*)(wt + WA_AU), AW, D, lds, tid, bid);
    convert_wt(a.in[18] + (size_t)l * SW * D, (bf16_t*)(wt + WA_SU), SW, D, lds, tid, bid);
    convert_wt(a.in[19] + (size_t)l * D * D, (bf16_t*)(wt + WA_OUT), D, D, lds, tid, bid);
}
__device__ __forceinline__ void convert_group_b(const Args& a, int l, unsigned char* wt, LAS unsigned char* lds, int tid, int bid) {
    convert_wt(a.in[22] + (size_t)l * D * DFF, (bf16_t*)(wt + WB_UP), D, DFF, lds, tid, bid);
    convert_wt(a.in[23] + (size_t)l * DFF * D, (bf16_t*)(wt + WB_DN), DFF, D, lds, tid, bid);
}

constexpr int AT_KSTR = 72, AT_VSTR = 296, AT_PSTR = 232;
constexpr int AT_K_OFF = 0, AT_V_OFF = 288 * AT_KSTR * 2, AT_P_OFF = AT_V_OFF + 64 * AT_VSTR * 2, AT_T_OFF = AT_P_OFF + 8 * 16 * AT_PSTR * 2, AT_END = AT_T_OFF + 4 * 132 * 4;
static_assert(AT_END <= LDS_BYTES, "attn lds");

__device__ __forceinline__ void attn_phase(const bf16_t* Qb, const bf16_t* Kb, const bf16_t* Vb, bf16_t* YA, const float* rel_bias, const float* sinks,
                                           LAS unsigned char* lds, int tid, int wave, int lane, int bid) {
    LAS bf16_t* vt = (LAS bf16_t*)(lds + AT_V_OFF);
    LAS float* tab = (LAS float*)(lds + AT_T_OFF);
    const int fr = lane & 15, quad = lane >> 4;
    for (int it = bid; it < NB * 32 * 4; it += gridDim.x) {
        const int b = it >> 7, nb = (it >> 2) & 31, kh = it & 3;
        for (int c = tid; c < 272 * 8; c += 512) {
            const int kk = c >> 3, part = c & 7;
            int row; bool ok = true;
            if (kk < 16) row = MSEQ + b * 16 + kk;
            else if (kk < 144) { row = b * SEQ + nb * 128 - 128 + (kk - 16); ok = nb > 0; }
            else row = b * SEQ + nb * 128 + (kk - 144);
            const int lr = kk < 16 ? kk : kk + 16;
            u32x4 kv = {0u, 0u, 0u, 0u}, vv = {0u, 0u, 0u, 0u};
            if (ok) { kv = *(const u32x4*)(Kb + (size_t)row * KVW + kh * 64 + part * 8); vv = *(const u32x4*)(Vb + (size_t)row * KVW + kh * 64 + part * 8); }
            *(LAS u32x4*)(lds + AT_K_OFF + (lr * AT_KSTR + part * 8) * 2) = kv;
#pragma unroll
            for (int e = 0; e < 8; ++e) vt[(part * 8 + e) * AT_VSTR + lr] = (bf16_t)(vv[e >> 1] >> ((e & 1) * 16));
        }
        for (int c = tid; c < 1024; c += 512) vt[(c >> 4) * AT_VSTR + 16 + (c & 15)] = 0;
        for (int c = tid; c < 4 * 129; c += 512) { const int g = c / 129, dd = c - g * 129; tab[g * 132 + dd] = rel_bias[t5_bucket(dd) * 16 + kh * 4 + g]; }
        __syncthreads();
        {
            const int g = wave >> 1, half = wave & 1, h = kh * 4 + g;
            const float sink = sinks[h];
            LAS bf16_t* Pw = (LAS bf16_t*)(lds + AT_P_OFF + wave * 16 * AT_PSTR * 2);
            for (int c = lane; c < 256; c += 64) Pw[(c >> 4) * AT_PSTR + 16 + (c & 15)] = 0;
            for (int rt = 0; rt < 4; ++rt) {
                const int iq0 = half * 64 + rt * 16;
                const size_t qrow = (size_t)(b * SEQ + nb * 128 + iq0 + fr);
                const bf16x8 qf0 = *(const bf16x8*)(Qb + qrow * AW + h * 64 + quad * 8), qf1 = *(const bf16x8*)(Qb + qrow * AW + h * 64 + 32 + quad * 8);
                f32x4 s[13];
#pragma unroll
                for (int kt = 0; kt < 13; ++kt) {
                    const int krow = (kt == 0) ? 0 : 32 + 64 * half + (kt - 1) * 16;
                    const bf16x8 k0 = *(const LAS bf16x8*)(lds + AT_K_OFF + ((krow + fr) * AT_KSTR + quad * 8) * 2);
                    const bf16x8 k1 = *(const LAS bf16x8*)(lds + AT_K_OFF + ((krow + fr) * AT_KSTR + 32 + quad * 8) * 2);
                    f32x4 z = {0.f, 0.f, 0.f, 0.f};
                    z = __builtin_amdgcn_mfma_f32_16x16x32_bf16(qf0, k0, z, 0, 0, 0);
                    s[kt] = __builtin_amdgcn_mfma_f32_16x16x32_bf16(qf1, k1, z, 0, 0, 0);
                    if (kt & 1) __builtin_amdgcn_sched_barrier(0);
                }
                float mx[4] = {sink, sink, sink, sink};
#pragma unroll
                for (int kt = 0; kt < 13; ++kt)
#pragma unroll
                    for (int j = 0; j < 4; ++j) {
                        const int iq = iq0 + quad * 4 + j; float v;
                        if (kt == 0) { int dist = nb * 128 + iq + 16 - fr; dist = dist > 128 ? 128 : dist; v = s[kt][j] * 0.125f + tab[g * 132 + dist]; }
                        else { const int kkr = 64 * half + (kt - 1) * 16 + fr, dist = iq + 128 - kkr;
                            const bool valid = (dist >= 0) && (dist < 128) && (nb > 0 || kkr >= 128);
                            v = valid ? s[kt][j] * 0.125f + tab[g * 132 + (dist & 127)] : -1e30f; }
                        s[kt][j] = v; mx[j] = fmaxf(mx[j], v);
                    }
                float l[4];
#pragma unroll
                for (int j = 0; j < 4; ++j) { mx[j] = row16_max(mx[j]); l[j] = 0.f; }
#pragma unroll
                for (int kt = 0; kt < 13; ++kt) {
                    const int pcol = (kt == 0) ? fr : 32 + (kt - 1) * 16 + fr;
#pragma unroll
                    for (int j = 0; j < 4; ++j) { const float p = __builtin_amdgcn_exp2f((s[kt][j] - mx[j]) * LOG2E); l[j] += p;
                        Pw[(quad * 4 + j) * AT_PSTR + pcol] = (bf16_t)(cvt_pk_bf16(p, p) & 0xffffu); }
                }
#pragma unroll
                for (int j = 0; j < 4; ++j) { l[j] = row16_sum(l[j]) + __builtin_amdgcn_exp2f((sink - mx[j]) * LOG2E); l[j] = 1.0f / l[j]; }
                asm volatile("s_waitcnt lgkmcnt(0)" ::: "memory");
                f32x4 o[4];
#pragma unroll
                for (int dt = 0; dt < 4; ++dt) o[dt] = (f32x4){0.f, 0.f, 0.f, 0.f};
#pragma unroll
                for (int ks = 0; ks < 7; ++ks) {
                    const int cb = (ks == 0) ? 0 : 32 + 64 * half + (ks - 1) * 32;
                    const bf16x8 pf = *(const LAS bf16x8*)(Pw + fr * AT_PSTR + ks * 32 + quad * 8);
#pragma unroll
                    for (int dt = 0; dt < 4; ++dt) { const bf16x8 vf = *(const LAS bf16x8*)(vt + (dt * 16 + fr) * AT_VSTR + cb + quad * 8);
                        o[dt] = __builtin_amdgcn_mfma_f32_16x16x32_bf16(pf, vf, o[dt], 0, 0, 0); }
                    __builtin_amdgcn_sched_barrier(0);
                }
#pragma unroll
                for (int j = 0; j < 4; ++j) { const size_t orow = (size_t)(b * SEQ + nb * 128 + iq0 + quad * 4 + j);
#pragma unroll
                    for (int dt = 0; dt < 4; ++dt) { const float ov = o[dt][j] * l[j]; YA[orow * AW + h * 64 + dt * 16 + fr] = (bf16_t)(cvt_pk_bf16(ov, ov) & 0xffffu); } }
                asm volatile("s_waitcnt lgkmcnt(0)" ::: "memory");
            }
        }
        __syncthreads();
    }
    if (bid < NB) {
        const int b = bid;
        LAS float* sc = (LAS float*)lds + tid * 17;
        if (tid < 256) {
            const int h = tid >> 4, i = tid & 15, kh = h >> 2;
            const float sink = sinks[h];
            const bf16_t* qp = Qb + (size_t)(MSEQ + b * 16 + i) * AW + h * 64;
            float mx = sink;
            for (int m = 0; m <= i; ++m) {
                const bf16_t* kp = Kb + (size_t)(MSEQ + b * 16 + m) * KVW + kh * 64;
                float dot = 0.f;
                for (int d8 = 0; d8 < 8; ++d8) { const u32x4 qw = *(const u32x4*)(qp + d8 * 8), kw = *(const u32x4*)(kp + d8 * 8);
#pragma unroll
                    for (int e = 0; e < 4; ++e) dot += bflo(qw[e]) * bflo(kw[e]) + bfhi(qw[e]) * bfhi(kw[e]); }
                const float sv = dot * 0.125f + rel_bias[(i - m) * 16 + h];
                sc[m] = sv; mx = fmaxf(mx, sv);
            }
            float l = __builtin_amdgcn_exp2f((sink - mx) * LOG2E);
            for (int m = 0; m <= i; ++m) { const float p = __builtin_amdgcn_exp2f((sc[m] - mx) * LOG2E); sc[m] = p; l += p; }
            const float inv = 1.0f / l;
            for (int d8 = 0; d8 < 8; ++d8) {
                float o[8];
#pragma unroll
                for (int e = 0; e < 8; ++e) o[e] = 0.f;
                for (int m = 0; m <= i; ++m) { const float p = sc[m]; const u32x4 vw = *(const u32x4*)(Vb + (size_t)(MSEQ + b * 16 + m) * KVW + kh * 64 + d8 * 8);
#pragma unroll
                    for (int e = 0; e < 4; ++e) { o[2 * e] += p * bflo(vw[e]); o[2 * e + 1] += p * bfhi(vw[e]); } }
                u32x4 w; w.x = cvt_pk_bf16(o[0] * inv, o[1] * inv); w.y = cvt_pk_bf16(o[2] * inv, o[3] * inv); w.z = cvt_pk_bf16(o[4] * inv, o[5] * inv); w.w = cvt_pk_bf16(o[6] * inv, o[7] * inv);
                *(u32x4*)(YA + (size_t)(MSEQ + b * 16 + i) * AW + h * 64 + d8 * 8) = w;
            }
        }
        __syncthreads();
    }
}

__device__ __forceinline__ void sincos_acc(float x, float& sn, float& cs) {
    const float k = rintf(x * 0.636619772367581f);
    float r = fmaf(-k, 1.5703125f, x); r = fmaf(-k, 4.837512969970703125e-4f, r); r = fmaf(-k, 7.54978995489188216e-8f, r);
    const float r2 = r * r;
    const float sp = r + r * r2 * (-1.6666654611e-1f + r2 * (8.3321608736e-3f + r2 * (-1.9515295891e-4f)));
    const float cp = 1.0f - 0.5f * r2 + r2 * r2 * (4.166664568298827e-2f + r2 * (-1.388731625493765e-3f + r2 * 2.443315711809948e-5f));
    const int q = ((int)k) & 3;
    sn = (q == 0) ? sp : (q == 1) ? cp : (q == 2) ? -sp : -cp;
    cs = (q == 0) ? cp : (q == 1) ? -sp : (q == 2) ? -cp : sp;
}

template <int PASS>
__device__ __forceinline__ void ssm_phase(const Args& a, int l, const bf16_t* U, bf16_t* Y, f32x2* SC, LAS unsigned char* lds, int wave, int lane, int bid) {
    const float* lam_re = a.in[8] + l * 4096; const float* lam_im = a.in[9] + l * 4096; const float* lstep = a.in[10] + l * 64;
    const float* b_re = a.in[11] + (size_t)l * 65536; const float* b_im = a.in[12] + (size_t)l * 65536;
    const float* c_re = a.in[13] + (size_t)l * 65536; const float* c_im = a.in[14] + (size_t)l * 65536; const float* dsk = a.in[15] + l * 1024;
    constexpr int NCH = (PASS == 1) ? 31 : 32;
    const int fr = lane & 15, quad = lane >> 4;
    LAS unsigned char* Hw = lds + wave * (16 * 272);
    for (int id = bid * 8 + wave; id < NB * 64 * NCH; id += gridDim.x * 8) {
        const int g = id & 63, c = (id >> 6) % NCH, b = id / (64 * NCH);
        const float lr = lam_re[g * 64 + lane], li = lam_im[g * 64 + lane], dt = expf(lstep[g]);
        const float decay = expf(lr * dt); float sn, cs; sincos_acc(li * dt, sn, cs);
        const float ar = decay * cs, ai = decay * sn;
        const float den = lr * lr + li * li, nr = ar - 1.0f, ni = ai;
        const float zr = (nr * lr + ni * li) / den, zi = (ni * lr - nr * li) / den;
        float bre[16], bim[16];
#pragma unroll
        for (int p4 = 0; p4 < 4; ++p4) { const f32x4 br = *(const f32x4*)(b_re + (size_t)(g * 64 + lane) * 16 + p4 * 4), bi = *(const f32x4*)(b_im + (size_t)(g * 64 + lane) * 16 + p4 * 4);
#pragma unroll
            for (int e = 0; e < 4; ++e) { bre[p4 * 4 + e] = zr * br[e] - zi * bi[e]; bim[p4 * 4 + e] = zr * bi[e] + zi * br[e]; } }
        bf16x8 cf[4]; float dskp = 0.f;
        if (PASS == 2) {
#pragma unroll
            for (int ks = 0; ks < 4; ++ks) { const f32x4 cr = *(const f32x4*)(c_re + (size_t)(g * 16 + fr) * 64 + ks * 16 + quad * 4), ci = *(const f32x4*)(c_im + (size_t)(g * 16 + fr) * 64 + ks * 16 + quad * 4);
                u32x4 w; w.x = cvt_pk_bf16(cr[0], -ci[0]); w.y = cvt_pk_bf16(cr[1], -ci[1]); w.z = cvt_pk_bf16(cr[2], -ci[2]); w.w = cvt_pk_bf16(cr[3], -ci[3]);
                cf[ks] = __builtin_bit_cast(bf16x8, w); }
            dskp = dsk[g * 16 + fr];
        }
        float hr = 0.f, hi = 0.f;
        if (PASS == 2 && c > 0) {
            float pr = ar, pi = ai;
#pragma unroll
            for (int q = 0; q < 7; ++q) { const float t = pr * pr - pi * pi; pi = 2.0f * pr * pi; pr = t; }
            const f32x2* sc = SC + ((size_t)(b * 64 + g) * 32) * 64 + lane;
            const f32x2 s0 = sc[0]; hr = s0.x; hi = s0.y;
            for (int cc = 1; cc < c; ++cc) { const f32x2 sv = sc[cc * 64]; const float t = pr * hr - pi * hi + sv.x; hi = pr * hi + pi * hr + sv.y; hr = t; }
        }
        const int nblk = (c == 0) ? 9 : 8;
#define SSM_ROWBASE(k) ((c == 0) ? ((k) == 0 ? MSEQ + b * 16 : b * SEQ + ((k) - 1) * 16) : b * SEQ + c * 128 + (k) * 16)
        u32x4 v = *(const u32x4*)(U + (size_t)(SSM_ROWBASE(0) + ((lane & 31) >> 1)) * SW + g * 16 + (lane & 1) * 8);
        for (int k = 0; k < nblk; ++k) {
            const int rb = SSM_ROWBASE(k);
            u32x4 vn = v;
            if (k + 1 < nblk) vn = *(const u32x4*)(U + (size_t)(SSM_ROWBASE(k + 1) + ((lane & 31) >> 1)) * SW + g * 16 + (lane & 1) * 8);
#pragma unroll 2
            for (int tt = 0; tt < 16; ++tt) {
                unsigned w[8];
#pragma unroll
                for (int d = 0; d < 4; ++d) { w[d] = (unsigned)__builtin_amdgcn_readlane((int)v[d], 2 * tt); w[4 + d] = (unsigned)__builtin_amdgcn_readlane((int)v[d], 2 * tt + 1); }
                float xr = 0.f, xi = 0.f;
#pragma unroll
                for (int d = 0; d < 8; ++d) { const float u0 = bflo(w[d]), u1 = bfhi(w[d]);
                    xr = fmaf(bre[2 * d], u0, xr); xi = fmaf(bim[2 * d], u0, xi); xr = fmaf(bre[2 * d + 1], u1, xr); xi = fmaf(bim[2 * d + 1], u1, xi); }
                const float nhr = fmaf(ar, hr, fmaf(-ai, hi, xr)), nhi = fmaf(ar, hi, fmaf(ai, hr, xi));
                hr = nhr; hi = nhi;
                if (PASS == 2) *(LAS unsigned*)(Hw + tt * 272 + lane * 4) = cvt_pk_bf16(hr, hi);
            }
            if (PASS == 2) {
                asm volatile("s_waitcnt lgkmcnt(0)" ::: "memory");
                f32x4 acc = {0.f, 0.f, 0.f, 0.f};
#pragma unroll
                for (int ks = 0; ks < 4; ++ks) { const bf16x8 af = *(const LAS bf16x8*)(Hw + fr * 272 + ks * 64 + quad * 16); acc = __builtin_amdgcn_mfma_f32_16x16x32_bf16(af, cf[ks], acc, 0, 0, 0); }
#pragma unroll
                for (int j = 0; j < 4; ++j) { const size_t row = (size_t)(rb + quad * 4 + j);
                    const float uu = bf2f(U[row * SW + g * 16 + fr]);
                    const float y = acc[j] + dskp * uu;
                    const float z2 = 1.5957691216f * (y + 0.044715f * y * y * y);
                    const float gy = y * __builtin_amdgcn_rcpf(1.0f + __builtin_amdgcn_exp2f(-z2 * LOG2E));
                    Y[row * SW + g * 16 + fr] = (bf16_t)(cvt_pk_bf16(gy, gy) & 0xffffu); }
                asm volatile("s_waitcnt lgkmcnt(0)" ::: "memory");
            }
            v = vn;
        }
#undef SSM_ROWBASE
        if (PASS == 1) SC[((size_t)(b * 64 + g) * 32 + c) * 64 + lane] = (f32x2){hr, hi};
    }
}

constexpr int NPHASE = 1 + 2 * 11;
__global__ void __launch_bounds__(512, 2) fwd_kernel(Args a) {
    extern __shared__ __attribute__((aligned(16))) unsigned char lds_raw[];
    LAS unsigned char* lds = (LAS unsigned char*)lds_raw;
    cg::grid_group grid = cg::this_grid();
    for (int ph = a.ph_lo; ph < a.ph_hi; ++ph) {
        int tid = threadIdx.x, bid = blockIdx.x;
        asm volatile("" : "+v"(tid)); asm volatile("" : "+s"(bid));
        const int lane = tid & 63, wave = __builtin_amdgcn_readfirstlane(tid >> 6);
        unsigned char* ws = a.ws;
        float* H32 = (float*)(ws + OFF_H32);
        bf16_t* HB = (bf16_t*)(ws + OFF_HB);
        unsigned char* pool = ws + OFF_POOL;
        bf16_t* Qb = (bf16_t*)(pool + PO_Q); bf16_t* Kb = (bf16_t*)(pool + PO_K); bf16_t* Vb = (bf16_t*)(pool + PO_V); bf16_t* Ub = (bf16_t*)(pool + PO_U);
        bf16_t* Gb = (bf16_t*)(pool + PO_G); bf16_t* YA = (bf16_t*)(pool + PO_YA);
        bf16_t* YS = HB;
        bf16_t* YG = Ub;
        bf16_t* F1 = (bf16_t*)pool;
        unsigned char* wt = ws + OFF_WT;
        f32x2* SC = (f32x2*)(ws + OFF_SC);
        const int l = (ph - 1) / 11, kind = (ph == 0) ? -1 : (ph - 1) % 11;
        bool is_gemm = false; pg8::Gemm g{nullptr, nullptr, MPAD, 0, 0}; pg8::EpiAll E{};
        if (kind == 0 && EN(0)) { is_gemm = true; g = pg8::Gemm{HB, (const bf16_t*)(wt + WA_IN), MPAD, INW, D};
            E.mode = 0; E.Q = Qb; E.Kb = Kb; E.Vb = Vb; E.U = Ub; E.G = Gb; E.gb = a.in[6] + (size_t)l * 4096; }
        else if (kind == 3 && EN(3)) { is_gemm = true; g = pg8::Gemm{YS, (const bf16_t*)(wt + WA_GLU), MPAD, SW, SW}; E.mode = 1; E.O = YG; E.ldc = SW; E.X = YS; E.ldx = SW; }
        else if (kind == 4 && EN(4)) { is_gemm = true; g = pg8::Gemm{YA, (const bf16_t*)(wt + WA_AU), MPAD, D, AW}; E.mode = 2; E.O = HB; E.ldc = D; E.X = Gb; E.ldx = 4096; }
        else if (kind == 5 && EN(4)) { is_gemm = true; g = pg8::Gemm{YG, (const bf16_t*)(wt + WA_SU), MPAD, D, SW}; E.mode = 3; E.O = HB; E.ldc = D; E.X = Gb + 2048; E.ldx = 4096; }
        else if (kind == 6 && EN(5)) { is_gemm = true; g = pg8::Gemm{HB, (const bf16_t*)(wt + WA_OUT), MPAD, D, D}; E.mode = 5; E.H = H32; }
        else if (kind == 8 && EN(7)) { is_gemm = true; g = pg8::Gemm{HB, (const bf16_t*)(wt + WB_UP), MPAD, DFF, D}; E.mode = 4; E.O = F1; E.ldc = DFF; }
        else if (kind == 9 && EN(8)) { is_gemm = true; g = pg8::Gemm{F1, (const bf16_t*)(wt + WB_DN), MPAD, D, DFF}; E.mode = 5; E.H = H32; }
        if (is_gemm) {
            pg8::StaticOrder S; S.init(MPAD, g.N, (int)gridDim.x, bid);
            pg8::gemm_phase(lds, g, S, E, tid);
        } else if (ph == 0 && EN(10)) {
            ln_phase<0>(a.in[0], a.in[1], a.in[2], a.in[3], H32, HB, nullptr, wave, lane, bid);
            convert_group_a(a, 0, wt, lds, tid, bid);
        } else if (kind == 1 && EN(1)) {
            attn_phase(Qb, Kb, Vb, YA, a.in[4], a.in[7] + l * 16, lds, tid, wave, lane, bid);
            ssm_phase<1>(a, l, Ub, YS, SC, lds, wave, lane, bid);
        } else if (kind == 2 && EN(2)) {
            ssm_phase<2>(a, l, Ub, YS, SC, lds, wave, lane, bid);
        } else if (kind == 7 && EN(6)) {
            ln_phase<1>(nullptr, nullptr, a.in[20] + l * D, a.in[21] + l * D, H32, HB, nullptr, wave, lane, bid);
            convert_group_b(a, l, wt, lds, tid, bid);
        } else if (kind == 10 && EN(9)) {
            if (l == 0) { ln_phase<1>(nullptr, nullptr, a.in[24], a.in[25], H32, HB, nullptr, wave, lane, bid); convert_group_a(a, 1, wt, lds, tid, bid); }
            else ln_phase<2>(nullptr, nullptr, a.in[24] + D, a.in[25] + D, H32, HB, a.out, wave, lane, bid);
        }
        if (ph + 1 < a.ph_hi && kind != 4) grid.sync();
    }
}

extern "C" void kernel_launch(void* const* d_in, const int* in_sizes, int n_in, void* d_out, int out_size, void* d_ws, size_t ws_size, hipStream_t stream) {
    static int grid = 0;
    if (grid == 0) {
        if (n_in != 26 || ws_size < WS_END) { fprintf(stderr, "kernel_launch: need 26 inputs and %zu bytes of workspace (got %d, %zu)\n", (size_t)WS_END, n_in, ws_size); grid = -1; return; }
        int dev = 0, cus = 0, per_cu = 0;
        (void)hipGetDevice(&dev);
        (void)hipDeviceGetAttribute(&cus, hipDeviceAttributeMultiprocessorCount, dev);
        if (hipFuncSetAttribute((const void*)fwd_kernel, hipFuncAttributeMaxDynamicSharedMemorySize, LDS_BYTES) != hipSuccess) { fprintf(stderr, "kernel_launch: hipFuncSetAttribute failed\n"); grid = -1; return; }
        if (hipOccupancyMaxActiveBlocksPerMultiprocessor(&per_cu, (const void*)fwd_kernel, 512, LDS_BYTES) != hipSuccess || per_cu < 1) { fprintf(stderr, "kernel_launch: occupancy query says %d\n", per_cu); per_cu = 1; }
        (void)hipGetLastError();
        grid = cus;
    }
    if (grid < 0) return;
    Args a{};
    for (int i = 0; i < 26; ++i) a.in[i] = (const float*)d_in[i];
    a.out = (float*)d_out; a.ws = (unsigned char*)d_ws; a.ph_lo = 0; a.ph_hi = NPHASE;
    void* args[] = {&a};
    hipError_t e = hipLaunchCooperativeKernel((const void*)fwd_kernel, dim3(grid), dim3(512), args, LDS_BYTES, stream);
    if (e != hipSuccess) fprintf(stderr, "kernel_launch: cooperative launch failed: %s (grid %d)\n", hipGetErrorString(e), grid);
}
```

```cpp
#include <hip/hip_runtime.h>
#include <hip/hip_cooperative_groups.h>
#include <cstdio>
namespace cg = cooperative_groups;

#define LAS __attribute__((address_space(3)))
typedef unsigned short bf16_t;
typedef short bf16x8 __attribute__((ext_vector_type(8)));
typedef float f32x4 __attribute__((ext_vector_type(4)));
typedef float f32x2 __attribute__((ext_vector_type(2)));
typedef unsigned u32x4 __attribute__((ext_vector_type(4)));
typedef unsigned u32x2 __attribute__((ext_vector_type(2)));

constexpr int D = 2048, NB = 4, SEQ = 4096, NMETA = 16;
constexpr int MSEQ = NB * SEQ;
constexpr int MROWS = MSEQ + NMETA;
constexpr int MPAD = MROWS;
constexpr int INW = 6656, DFF = 8192, AW = 1024, KVW = 256, SW = 1024;
constexpr float DN_ALPHA = 1.41421356237f;
constexpr float LOG2E = 1.44269504089f;

constexpr size_t OFF_H32 = 0;
constexpr size_t SZ_H32 = (size_t)MPAD * D * 4;
constexpr size_t OFF_HB = OFF_H32 + SZ_H32;
constexpr size_t SZ_HB = (size_t)MPAD * D * 2;
constexpr size_t OFF_POOL = OFF_HB + SZ_HB;
constexpr size_t SZ_POOL = (size_t)MPAD * DFF * 2;
constexpr size_t PO_Q = 0;
constexpr size_t PO_K = PO_Q + (size_t)MPAD * AW * 2;
constexpr size_t PO_V = PO_K + (size_t)MPAD * KVW * 2;
constexpr size_t PO_U = PO_V + (size_t)MPAD * KVW * 2;
constexpr size_t PO_G = PO_U + (size_t)MPAD * SW * 2;
constexpr size_t PO_YA = PO_G + (size_t)MPAD * 4096 * 2;
static_assert(PO_YA + (size_t)MPAD * AW * 2 <= SZ_POOL, "pool");
constexpr size_t OFF_WT = OFF_POOL + SZ_POOL;
constexpr size_t SZ_WT = (size_t)2 * D * DFF * 2;
constexpr size_t WA_IN = 0;
constexpr size_t WA_GLU = WA_IN + (size_t)INW * D * 2;
constexpr size_t WA_AU = WA_GLU + (size_t)SW * SW * 2;
constexpr size_t WA_SU = WA_AU + (size_t)AW * D * 2;
constexpr size_t WA_OUT = WA_SU + (size_t)SW * D * 2;
static_assert(WA_OUT + (size_t)D * D * 2 <= SZ_WT, "wt");
constexpr size_t WB_UP = 0;
constexpr size_t WB_DN = (size_t)D * DFF * 2;
constexpr size_t OFF_SC = OFF_WT + SZ_WT;
constexpr size_t SZ_SC = (size_t)NB * 64 * 32 * 64 * 8;
constexpr size_t WS_END = OFF_SC + SZ_SC;

constexpr int LDS_BYTES = 140864;
#ifndef ONLY
#define ONLY -1
#endif
#ifndef MASK
#define MASK 0xFFFF
#endif
#define EN(k) (((MASK) >> (k)) & 1)

struct Args { const float* in[26]; float* out; unsigned char* ws; int ph_lo, ph_hi; };

__device__ __forceinline__ unsigned cvt_pk_bf16(float lo, float hi) { unsigned r; asm volatile("v_cvt_pk_bf16_f32 %0, %1, %2" : "=v"(r) : "v"(lo), "v"(hi)); return r; }
__device__ __forceinline__ float bflo(unsigned w) { return __uint_as_float(w << 16); }
__device__ __forceinline__ float bfhi(unsigned w) { return __uint_as_float(w & 0xffff0000u); }
__device__ __forceinline__ float bf2f(bf16_t v) { return __uint_as_float(((unsigned)v) << 16); }
__device__ __forceinline__ float sigmoid_f(float x) { return __builtin_amdgcn_rcpf(1.0f + __builtin_amdgcn_exp2f(-x * LOG2E)); }
template <int CTRL> __device__ __forceinline__ float dpp_f(float v) { return __int_as_float(__builtin_amdgcn_update_dpp(0, __float_as_int(v), CTRL, 0xf, 0xf, true)); }
__device__ __forceinline__ float row16_max(float v) { v = fmaxf(v, dpp_f<0xB1>(v)); v = fmaxf(v, dpp_f<0x4E>(v)); v = fmaxf(v, dpp_f<0x141>(v)); v = fmaxf(v, dpp_f<0x140>(v)); return v; }
__device__ __forceinline__ float row16_sum(float v) { v += dpp_f<0xB1>(v); v += dpp_f<0x4E>(v); v += dpp_f<0x141>(v); v += dpp_f<0x140>(v); return v; }
__device__ __forceinline__ float wave_sum(float v) { for (int o = 32; o > 0; o >>= 1) v += __shfl_xor(v, o); return v; }
__device__ __forceinline__ int t5_bucket(int n) {
    if (n < 16) return n;
    return 16 + (n >= 19) + (n >= 21) + (n >= 24) + (n >= 27) + (n >= 31) + (n >= 35) + (n >= 40) + (n >= 46) + (n >= 52) + (n >= 59) + (n >= 67) + (n >= 77) + (n >= 87) + (n >= 99) + (n >= 113);
}

namespace pg8 {
constexpr int BM = 256, BK = 64, HALF = 128, HTB = HALF * BK * 2, STAGE_BYTES = 8 * HTB, NXCD = 8, WGM = 8;
__device__ __forceinline__ int lds_byte(int r, int c) { const int st = (r >> 4) * 2 + (c >> 5), rr = r & 15, cc = c & 31, ob = rr * 64 + cc * 2; return st * 1024 + (ob ^ (((ob >> 9) & 1) << 5)); }
__device__ __forceinline__ void stage_rc(int b, int& R, int& C) { const int st = b / 1024, sb = b % 1024, swz = sb ^ (((sb >> 9) & 1) << 5); R = (st >> 1) * 16 + swz / 64; C = (st & 1) * 32 + (swz % 64) / 2; }
__device__ __forceinline__ int perm32(int rho) { const int n = rho >> 4, i = rho & 15; return 8 * (i >> 2) + 4 * n + (i & 3); }
struct Unit { int pm, pn; };
struct Gemm { const bf16_t* A; const bf16_t* Bt; int M, N, K; };
struct StaticOrder {
    int nM, nN, nwg, G, c;
    __device__ void init(int M, int N, int G_, int c_) { nM = M / BM; nN = N / BM; nwg = nM * nN; G = G_; c = c_; }
    __device__ bool next(int i, Unit& u) const {
        const long L = (long)i * G + c; if (L >= nwg) return false;
        int wgid = (int)L; { const int q = nwg / NXCD, r = nwg % NXCD, xcd = wgid % NXCD, off = wgid / NXCD; wgid = (xcd < r ? xcd * (q + 1) : r * (q + 1) + (xcd - r) * q) + off; }
        const int nig = WGM * nN, gid = wgid / nig, fm = gid * WGM, gsz = (nM - fm) < WGM ? (nM - fm) : WGM;
        u.pm = fm + ((wgid % nig) % gsz); u.pn = (wgid % nig) / gsz; return true;
    }
};
template <class Epi>
__device__ __forceinline__ void gemm_phase(LAS unsigned char* lds, const Gemm g, const StaticOrder& S, const Epi& E, const int tid) {
    const int wid = __builtin_amdgcn_readfirstlane(tid >> 6), lane = tid & 63, wr = wid >> 2, wc = wid & 3, fr = lane & 15, fq = lane >> 4;
    const int K = g.K, nt = K / BK;
    unsigned voffA[2], voffB[2];
#pragma unroll
    for (int i = 0; i < 2; ++i) { int R, C; stage_rc(tid * 16 + i * 8192, R, C); const int Rb = E.perm() ? ((R & ~31) + perm32(R & 31)) : R;
        voffA[i] = (unsigned)(R * K + C) * 2u; voffB[i] = (unsigned)(Rb * K + C) * 2u; }
    const size_t kstep = (size_t)(BK * 2);
    const size_t hstep = (size_t)HALF * K * 2;
    const size_t tstep = 2 * hstep;
    const unsigned ldsw = (unsigned)wid * 1024u;
    const int aoff = lds_byte(wr * 64 + fr, fq * 8), boff = lds_byte(wc * 32 + fr, fq * 8);
#define PG8_SA(b, h) (((b) * 2 + (h)) * HTB)
#define PG8_SB(b, h) ((4 + (b) * 2 + (h)) * HTB)
#define PG8_STAGE(bufoff, gbase, voff) do { _Pragma("unroll") for (int _i = 0; _i < 2; ++_i) \
        __builtin_amdgcn_global_load_lds((const unsigned*)((const char*)(gbase) + (voff)[_i]), (LAS unsigned*)(lds + (bufoff) + ldsw + _i * 8192), 16, 0, 0); } while (0)
#define PG8_LDA(dst, b, h) do { _Pragma("unroll") for (int m = 0; m < 4; ++m) _Pragma("unroll") for (int k = 0; k < 2; ++k) dst[m][k] = *(const LAS bf16x8*)(lds + PG8_SA(b, h) + aoff + m * 2048 + k * 1024); } while (0)
#define PG8_LDB(dst, b, h) do { _Pragma("unroll") for (int n = 0; n < 2; ++n) _Pragma("unroll") for (int k = 0; k < 2; ++k) dst[n][k] = *(const LAS bf16x8*)(lds + PG8_SB(b, h) + boff + n * 2048 + k * 1024); } while (0)
#define PG8_MMA(ai, bj, At, Bt) do { __builtin_amdgcn_s_setprio(1); _Pragma("unroll") for (int m = 0; m < 4; ++m) _Pragma("unroll") for (int n = 0; n < 2; ++n) _Pragma("unroll") for (int k = 0; k < 2; ++k) \
        acc[ai][bj][m][n] = __builtin_amdgcn_mfma_f32_16x16x32_bf16(Bt[n][k], At[m][k], acc[ai][bj][m][n], 0, 0, 0); __builtin_amdgcn_s_setprio(0); } while (0)
#define PG8_WAIT_V(n) asm volatile("s_waitcnt vmcnt(" #n ")" ::: "memory")
#define PG8_WAIT_L(n) asm volatile("s_waitcnt lgkmcnt(" #n ")" ::: "memory")
#define PG8_BAR __builtin_amdgcn_s_barrier()
#define PG8_SCHED __builtin_amdgcn_sched_barrier(0)
    Unit cur, nxt; int ui = 0;
    if (!S.next(0, cur)) return;
    f32x4 acc[2][2][4][2];
#pragma unroll
    for (int a = 0; a < 2; ++a)
#pragma unroll
        for (int b = 0; b < 2; ++b)
#pragma unroll
            for (int m = 0; m < 4; ++m)
#pragma unroll
                for (int n = 0; n < 2; ++n) acc[a][b][m][n] = (f32x4){0.f, 0.f, 0.f, 0.f};
    bf16x8 At[4][2], B0[2][2], B1[2][2];
    const char* cA = (const char*)g.A + (size_t)cur.pm * tstep; const char* cB = (const char*)g.Bt + (size_t)cur.pn * tstep;
    PG8_STAGE(PG8_SB(0, 0), cB, voffB); PG8_STAGE(PG8_SA(0, 0), cA, voffA); PG8_STAGE(PG8_SB(0, 1), cB + hstep, voffB); PG8_STAGE(PG8_SA(0, 1), cA + hstep, voffA);
    if (wr == 1) PG8_BAR;
    PG8_WAIT_V(4); PG8_BAR;
    PG8_STAGE(PG8_SB(1, 0), cB + kstep, voffB); PG8_STAGE(PG8_SA(1, 0), cA + kstep, voffA); PG8_STAGE(PG8_SB(1, 1), cB + hstep + kstep, voffB);
    PG8_WAIT_V(6); PG8_BAR;
    for (;;) {
        const bool has_next = S.next(ui + 1, nxt);
        const char* nA = has_next ? (const char*)g.A + (size_t)nxt.pm * tstep : cA; const char* nB = has_next ? (const char*)g.Bt + (size_t)nxt.pn * tstep : cB;
        for (int t = 0; t < nt; t += 2) {
            const bool last = (t == nt - 2);
            const char* a1 = cA + (size_t)(t + 1) * kstep;
            const char* a2 = last ? nA : cA + (size_t)(t + 2) * kstep; const char* b2 = last ? nB : cB + (size_t)(t + 2) * kstep;
            const char* a3 = a2 + kstep; const char* b3 = b2 + kstep;
            PG8_LDB(B0, 0, 0); PG8_SCHED; PG8_LDA(At, 0, 0); PG8_STAGE(PG8_SA(1, 1), a1 + hstep, voffA);
            PG8_WAIT_L(8); PG8_BAR; PG8_WAIT_L(0); PG8_MMA(0, 0, At, B0); PG8_BAR; PG8_SCHED;
            PG8_LDB(B1, 0, 1); PG8_STAGE(PG8_SB(0, 0), b2, voffB);
            PG8_BAR; PG8_WAIT_L(0); PG8_MMA(0, 1, At, B1); PG8_BAR;
            PG8_LDA(At, 0, 1); PG8_STAGE(PG8_SA(0, 0), a2, voffA);
            PG8_BAR; PG8_WAIT_L(0); PG8_MMA(1, 0, At, B0); PG8_BAR; PG8_SCHED;
            PG8_STAGE(PG8_SB(0, 1), b2 + hstep, voffB);
            PG8_WAIT_V(6); PG8_BAR; PG8_MMA(1, 1, At, B1); PG8_BAR;
            PG8_LDB(B0, 1, 0); PG8_SCHED; PG8_LDA(At, 1, 0); PG8_STAGE(PG8_SA(0, 1), a2 + hstep, voffA);
            PG8_WAIT_L(8); PG8_BAR; PG8_WAIT_L(0); PG8_MMA(0, 0, At, B0); PG8_BAR; PG8_SCHED;
            PG8_LDB(B1, 1, 1); PG8_STAGE(PG8_SB(1, 0), b3, voffB);
            PG8_BAR; PG8_WAIT_L(0); PG8_MMA(0, 1, At, B1); PG8_BAR;
            PG8_LDA(At, 1, 1); PG8_STAGE(PG8_SA(1, 0), a3, voffA);
            PG8_BAR; PG8_WAIT_L(0); PG8_MMA(1, 0, At, B0); PG8_BAR; PG8_SCHED;
            PG8_STAGE(PG8_SB(1, 1), b3 + hstep, voffB);
            PG8_WAIT_V(6); PG8_BAR; PG8_MMA(1, 1, At, B1); PG8_BAR;
        }
        E(acc, cur, wr, wc, fr, fq);
        if (!has_next) break;
#pragma unroll
        for (int a = 0; a < 2; ++a)
#pragma unroll
            for (int b = 0; b < 2; ++b)
#pragma unroll
                for (int m = 0; m < 4; ++m)
#pragma unroll
                    for (int n = 0; n < 2; ++n) acc[a][b][m][n] = (f32x4){0.f, 0.f, 0.f, 0.f};
        cur = nxt; cA = nA; cB = nB; ++ui;
    }
    PG8_WAIT_V(0);
    if (wr == 0) PG8_BAR;
    PG8_BAR;
#undef PG8_SA
#undef PG8_SB
#undef PG8_STAGE
#undef PG8_LDA
#undef PG8_LDB
#undef PG8_MMA
#undef PG8_WAIT_V
#undef PG8_WAIT_L
#undef PG8_BAR
#undef PG8_SCHED
}

typedef f32x4 Acc[2][2][4][2];
struct EpiAll {
    int mode;
    bf16_t* O; int ldc; const bf16_t* X; int ldx; float* H;
    bf16_t *Q, *Kb, *Vb, *U, *G; const float* gb;
    __device__ __forceinline__ bool perm() const { return mode != 5; }
    __device__ __forceinline__ void operator()(const Acc& acc, const Unit& u, int wr, int wc, int fr, int fq) const {
        if (mode == 5) {
            const int row0 = u.pm * BM + wr * 64 + fr, col0 = u.pn * BM + wc * 32 + 4 * fq;
#pragma unroll
            for (int ai = 0; ai < 2; ++ai)
#pragma unroll
                for (int m = 0; m < 4; ++m) { float* rowp = H + (size_t)(row0 + ai * HALF + m * 16) * D + col0;
#pragma unroll
                    for (int bj = 0; bj < 2; ++bj)
#pragma unroll
                        for (int n = 0; n < 2; ++n) { f32x4* p = (f32x4*)(rowp + bj * HALF + n * 16); const f32x4 h = *p; *p = h * DN_ALPHA + acc[ai][bj][m][n]; } }
            return;
        }
        bf16_t* base = O; int ld = ldc, colt = u.pn * BM; bool gate = false;
        if (mode == 0) { const int pn = u.pn;
            if (pn < 4) { base = Q; ld = AW; colt = pn * 256; }
            else if (pn == 4) { base = Kb; ld = KVW; colt = 0; }
            else if (pn == 5) { base = Vb; ld = KVW; colt = 0; }
            else if (pn < 10) { base = U; ld = SW; colt = (pn - 6) * 256; }
            else { base = G; ld = 4096; colt = (pn - 10) * 256; gate = true; } }
        const int row0 = u.pm * BM + wr * 64 + fr, col0 = colt + wc * 32 + 8 * fq;
        f32x4 bv[2][2];
#pragma unroll
        for (int bj = 0; bj < 2; ++bj)
#pragma unroll
            for (int n = 0; n < 2; ++n) bv[bj][n] = gate ? *(const f32x4*)(gb + col0 + bj * HALF + 4 * n) : (f32x4){0.f, 0.f, 0.f, 0.f};
#pragma unroll
        for (int ai = 0; ai < 2; ++ai)
#pragma unroll
            for (int m = 0; m < 4; ++m) { const size_t r = (size_t)(row0 + ai * HALF + m * 16);
#pragma unroll
                for (int bj = 0; bj < 2; ++bj) { f32x4 v0 = acc[ai][bj][m][0] + bv[bj][0], v1 = acc[ai][bj][m][1] + bv[bj][1];
                    bf16_t* op = base + r * ld + col0 + bj * HALF;
                    if (mode == 0) {
                        if (gate) {
#pragma unroll
                            for (int j = 0; j < 4; ++j) { v0[j] = sigmoid_f(v0[j]); v1[j] = sigmoid_f(v1[j]); } }
                    } else if (mode == 4) {
#pragma unroll
                        for (int j = 0; j < 4; ++j) { const float a0 = fmaxf(v0[j], 0.f), a1 = fmaxf(v1[j], 0.f); v0[j] = a0 * a0; v1[j] = a1 * a1; }
                    } else {
                        const u32x4 xw = *(const u32x4*)(X + r * ldx + col0 + bj * HALF);
                        const f32x4 x0 = {bflo(xw.x), bfhi(xw.x), bflo(xw.y), bfhi(xw.y)}, x1 = {bflo(xw.z), bfhi(xw.z), bflo(xw.w), bfhi(xw.w)};
                        if (mode == 1) {
#pragma unroll
                            for (int j = 0; j < 4; ++j) { v0[j] = x0[j] * sigmoid_f(v0[j]); v1[j] = x1[j] * sigmoid_f(v1[j]); }
                        } else { v0 = v0 * x0; v1 = v1 * x1;
                            if (mode == 3) { const u32x4 ow = *(const u32x4*)op;
                                const f32x4 o0 = {bflo(ow.x), bfhi(ow.x), bflo(ow.y), bfhi(ow.y)}, o1 = {bflo(ow.z), bfhi(ow.z), bflo(ow.w), bfhi(ow.w)};
                                v0 = v0 + o0; v1 = v1 + o1; } }
                    }
                    u32x4 w; w.x = cvt_pk_bf16(v0[0], v0[1]); w.y = cvt_pk_bf16(v0[2], v0[3]); w.z = cvt_pk_bf16(v1[0], v1[1]); w.w = cvt_pk_bf16(v1[2], v1[3]);
                    *(u32x4*)op = w; } }
    }
};
}

template <int MODE>
__device__ __forceinline__ void ln_phase(const float* x, const float* meta, const float* gam, const float* bet, float* H32, bf16_t* HB, float* out, int wave, int lane, int bid) {
    const int gw = bid * 8 + wave, nw = gridDim.x * 8;
    const int nrows = (MODE == 2) ? MSEQ : MPAD;
    for (int r = gw; r < nrows; r += nw) {
        const float* src;
        if (MODE == 0) src = (r < MSEQ) ? x + (size_t)r * D : meta + (size_t)(r - MSEQ) * D;
        else src = H32 + (size_t)r * D;
        f32x4 v[8];
        if (src) {
#pragma unroll
            for (int i = 0; i < 8; ++i) v[i] = *(const f32x4*)(src + i * 256 + lane * 4);
            float s = 0.f;
#pragma unroll
            for (int i = 0; i < 8; ++i) s += (v[i][0] + v[i][1]) + (v[i][2] + v[i][3]);
            const float mu = wave_sum(s) * (1.0f / D);
            float q = 0.f;
#pragma unroll
            for (int i = 0; i < 8; ++i) { v[i] = v[i] - mu; q += (v[i][0] * v[i][0] + v[i][1] * v[i][1]) + (v[i][2] * v[i][2] + v[i][3] * v[i][3]); }
            const float rstd = 1.0f / sqrtf(wave_sum(q) * (1.0f / D) + 1e-5f);
#pragma unroll
            for (int i = 0; i < 8; ++i) { const f32x4 g4 = *(const f32x4*)(gam + i * 256 + lane * 4), b4 = *(const f32x4*)(bet + i * 256 + lane * 4); v[i] = v[i] * rstd * g4 + b4; }
        } else {
#pragma unroll
            for (int i = 0; i < 8; ++i) v[i] = (f32x4){0.f, 0.f, 0.f, 0.f};
        }
        if (MODE == 2) {
#pragma unroll
            for (int i = 0; i < 8; ++i) *(f32x4*)(out + (size_t)r * D + i * 256 + lane * 4) = v[i];
        } else {
#pragma unroll
            for (int i = 0; i < 8; ++i) { *(f32x4*)(H32 + (size_t)r * D + i * 256 + lane * 4) = v[i];
                u32x2 w; w.x = cvt_pk_bf16(v[i][0], v[i][1]); w.y = cvt_pk_bf16(v[i][2], v[i][3]); *(u32x2*)(HB + (size_t)r * D + i * 256 + lane * 4) = w; }
        }
    }
}

__device__ __forceinline__ void convert_wt(const float* __restrict__ W, bf16_t* __restrict__ Wt, int K, int N, int wave, int lane, int bid) {
    const int tn = N / 64, ntile = tn * (K / 64);
    for (int t = bid * 8 + wave; t < ntile; t += gridDim.x * 8) {
        const int k0 = (t / tn) * 64, n0 = (t % tn) * 64;
        const float* src = W + (size_t)k0 * N + n0 + lane;
        float f[64];
#pragma unroll
        for (int e = 0; e < 64; ++e) f[e] = src[(size_t)e * N];
        bf16_t* dst = Wt + (size_t)(n0 + lane) * K + k0;
#pragma unroll
        for (int kg = 0; kg < 8; ++kg) { u32x4 w; w.x = cvt_pk_bf16(f[kg * 8 + 0], f[kg * 8 + 1]); w.y = cvt_pk_bf16(f[kg * 8 + 2], f[kg * 8 + 3]); w.z = cvt_pk_bf16(f[kg * 8 + 4], f[kg * 8 + 5]); w.w = cvt_pk_bf16(f[kg * 8 + 6], f[kg * 8 + 7]);
            *(u32x4*)(dst + kg * 8) = w; }
    }
}
__device__ __forceinline__ void convert_group_a(const Args& a, int l, unsigned char* wt, int wave, int lane, int bid) {
    convert_wt(a.in[5] + (size_t)l * D * INW, (bf16_t*)(wt + WA_IN), D, INW, wave, lane, bid);
    convert_wt(a.in[16] + (size_t)l * SW * SW, (bf16_t*)(wt + WA_GLU), SW, SW, wave, lane, bid);
    convert_wt(a.in[17] + (size_t)l * AW * D, (bf16_t*)(wt + WA_AU), AW, D, wave, lane, bid);
    convert_wt(a.in[18] + (size_t)l * SW * D, (bf16_t*)(wt + WA_SU), SW, D, wave, lane, bid);
    convert_wt(a.in[19] + (size_t)l * D * D, (bf16_t*)(wt + WA_OUT), D, D, wave, lane, bid);
}
__device__ __forceinline__ void convert_group_b(const Args& a, int l, unsigned char* wt, int wave, int lane, int bid) {
    convert_wt(a.in[22] + (size_t)l * D * DFF, (bf16_t*)(wt + WB_UP), D, DFF, wave, lane, bid);
    convert_wt(a.in[23] + (size_t)l * DFF * D, (bf16_t*)(wt + WB_DN), DFF, D, wave, lane, bid);
}

constexpr int AT_KSTR = 72, AT_VSTR = 296, AT_PSTR = 232;
constexpr int AT_K_OFF = 0, AT_V_OFF = 288 * AT_KSTR * 2, AT_P_OFF = AT_V_OFF + 64 * AT_VSTR * 2, AT_T_OFF = AT_P_OFF + 8 * 16 * AT_PSTR * 2, AT_END = AT_T_OFF + 4 * 132 * 4;
static_assert(AT_END <= LDS_BYTES, "attn lds");

__device__ __forceinline__ void attn_phase(const bf16_t* Qb, const bf16_t* Kb, const bf16_t* Vb, bf16_t* YA, const float* rel_bias, const float* sinks,
                                           LAS unsigned char* lds, int tid, int wave, int lane, int bid) {
    LAS bf16_t* vt = (LAS bf16_t*)(lds + AT_V_OFF);
    LAS float* tab = (LAS float*)(lds + AT_T_OFF);
    const int fr = lane & 15, quad = lane >> 4;
    for (int it = bid; it < NB * 32 * 4; it += gridDim.x) {
        const int b = it >> 7, nb = (it >> 2) & 31, kh = it & 3;
        for (int c = tid; c < 272 * 8; c += 512) {
            const int kk = c >> 3, part = c & 7;
            int row; bool ok = true;
            if (kk < 16) row = MSEQ + kk;
            else if (kk < 144) { row = b * SEQ + nb * 128 - 128 + (kk - 16); ok = nb > 0; }
            else row = b * SEQ + nb * 128 + (kk - 144);
            const int lr = kk < 16 ? kk : kk + 16;
            u32x4 kv = {0u, 0u, 0u, 0u}, vv = {0u, 0u, 0u, 0u};
            if (ok) { kv = *(const u32x4*)(Kb + (size_t)row * KVW + kh * 64 + part * 8); vv = *(const u32x4*)(Vb + (size_t)row * KVW + kh * 64 + part * 8); }
            *(LAS u32x4*)(lds + AT_K_OFF + (lr * AT_KSTR + part * 8) * 2) = kv;
#pragma unroll
            for (int e = 0; e < 8; ++e) vt[(part * 8 + e) * AT_VSTR + lr] = (bf16_t)(vv[e >> 1] >> ((e & 1) * 16));
        }
        for (int c = tid; c < 1024; c += 512) vt[(c >> 4) * AT_VSTR + 16 + (c & 15)] = 0;
        for (int c = tid; c < 4 * 129; c += 512) { const int g = c / 129, dd = c - g * 129; tab[g * 132 + dd] = rel_bias[t5_bucket(dd) * 16 + kh * 4 + g]; }
        __syncthreads();
        {
            const int g = wave >> 1, half = wave & 1, h = kh * 4 + g;
            const float sink = sinks[h];
            LAS bf16_t* Pw = (LAS bf16_t*)(lds + AT_P_OFF + wave * 16 * AT_PSTR * 2);
            for (int c = lane; c < 256; c += 64) Pw[(c >> 4) * AT_PSTR + 16 + (c & 15)] = 0;
            for (int rt = 0; rt < 4; ++rt) {
                const int iq0 = half * 64 + rt * 16;
                const size_t qrow = (size_t)(b * SEQ + nb * 128 + iq0 + fr);
                const bf16x8 qf0 = *(const bf16x8*)(Qb + qrow * AW + h * 64 + quad * 8), qf1 = *(const bf16x8*)(Qb + qrow * AW + h * 64 + 32 + quad * 8);
                f32x4 s[13];
#pragma unroll
                for (int kt = 0; kt < 13; ++kt) {
                    const int krow = (kt == 0) ? 0 : 32 + 64 * half + (kt - 1) * 16;
                    const bf16x8 k0 = *(const LAS bf16x8*)(lds + AT_K_OFF + ((krow + fr) * AT_KSTR + quad * 8) * 2);
                    const bf16x8 k1 = *(const LAS bf16x8*)(lds + AT_K_OFF + ((krow + fr) * AT_KSTR + 32 + quad * 8) * 2);
                    f32x4 z = {0.f, 0.f, 0.f, 0.f};
                    z = __builtin_amdgcn_mfma_f32_16x16x32_bf16(qf0, k0, z, 0, 0, 0);
                    s[kt] = __builtin_amdgcn_mfma_f32_16x16x32_bf16(qf1, k1, z, 0, 0, 0);
                    if (kt & 1) __builtin_amdgcn_sched_barrier(0);
                }
                float mx[4] = {sink, sink, sink, sink};
#pragma unroll
                for (int kt = 0; kt < 13; ++kt)
#pragma unroll
                    for (int j = 0; j < 4; ++j) {
                        const int iq = iq0 + quad * 4 + j; float v;
                        if (kt == 0) { int dist = nb * 128 + iq + 16 - fr; dist = dist > 128 ? 128 : dist; v = s[kt][j] * 0.125f + tab[g * 132 + dist]; }
                        else { const int kkr = 64 * half + (kt - 1) * 16 + fr, dist = iq + 128 - kkr;
                            const bool valid = (dist >= 0) && (dist < 128) && (nb > 0 || kkr >= 128);
                            v = valid ? s[kt][j] * 0.125f + tab[g * 132 + (dist & 127)] : -1e30f; }
                        s[kt][j] = v; mx[j] = fmaxf(mx[j], v);
                    }
                float l[4];
#pragma unroll
                for (int j = 0; j < 4; ++j) { mx[j] = row16_max(mx[j]); l[j] = 0.f; }
#pragma unroll
                for (int kt = 0; kt < 13; ++kt) {
                    const int pcol = (kt == 0) ? fr : 32 + (kt - 1) * 16 + fr;
#pragma unroll
                    for (int j = 0; j < 4; ++j) { const float p = __builtin_amdgcn_exp2f((s[kt][j] - mx[j]) * LOG2E); l[j] += p;
                        Pw[(quad * 4 + j) * AT_PSTR + pcol] = (bf16_t)(cvt_pk_bf16(p, p) & 0xffffu); }
                }
#pragma unroll
                for (int j = 0; j < 4; ++j) { l[j] = row16_sum(l[j]) + __builtin_amdgcn_exp2f((sink - mx[j]) * LOG2E); l[j] = 1.0f / l[j]; }
                asm volatile("s_waitcnt lgkmcnt(0)" ::: "memory");
                f32x4 o[4];
#pragma unroll
                for (int dt = 0; dt < 4; ++dt) o[dt] = (f32x4){0.f, 0.f, 0.f, 0.f};
#pragma unroll
                for (int ks = 0; ks < 7; ++ks) {
                    const int cb = (ks == 0) ? 0 : 32 + 64 * half + (ks - 1) * 32;
                    const bf16x8 pf = *(const LAS bf16x8*)(Pw + fr * AT_PSTR + ks * 32 + quad * 8);
#pragma unroll
                    for (int dt = 0; dt < 4; ++dt) { const bf16x8 vf = *(const LAS bf16x8*)(vt + (dt * 16 + fr) * AT_VSTR + cb + quad * 8);
                        o[dt] = __builtin_amdgcn_mfma_f32_16x16x32_bf16(pf, vf, o[dt], 0, 0, 0); }
                    __builtin_amdgcn_sched_barrier(0);
                }
#pragma unroll
                for (int j = 0; j < 4; ++j) { const size_t orow = (size_t)(b * SEQ + nb * 128 + iq0 + quad * 4 + j);
#pragma unroll
                    for (int dt = 0; dt < 4; ++dt) { const float ov = o[dt][j] * l[j]; YA[orow * AW + h * 64 + dt * 16 + fr] = (bf16_t)(cvt_pk_bf16(ov, ov) & 0xffffu); } }
                asm volatile("s_waitcnt lgkmcnt(0)" ::: "memory");
            }
        }
        __syncthreads();
    }
    if (bid == 0) {
        LAS float* sc = (LAS float*)lds + tid * 17;
        if (tid < 256) {
            const int h = tid >> 4, i = tid & 15, kh = h >> 2;
            const float sink = sinks[h];
            const bf16_t* qp = Qb + (size_t)(MSEQ + i) * AW + h * 64;
            float mx = sink;
            for (int m = 0; m <= i; ++m) {
                const bf16_t* kp = Kb + (size_t)(MSEQ + m) * KVW + kh * 64;
                float dot = 0.f;
                for (int d8 = 0; d8 < 8; ++d8) { const u32x4 qw = *(const u32x4*)(qp + d8 * 8), kw = *(const u32x4*)(kp + d8 * 8);
#pragma unroll
                    for (int e = 0; e < 4; ++e) dot += bflo(qw[e]) * bflo(kw[e]) + bfhi(qw[e]) * bfhi(kw[e]); }
                const float sv = dot * 0.125f + rel_bias[(i - m) * 16 + h];
                sc[m] = sv; mx = fmaxf(mx, sv);
            }
            float l = __builtin_amdgcn_exp2f((sink - mx) * LOG2E);
            for (int m = 0; m <= i; ++m) { const float p = __builtin_amdgcn_exp2f((sc[m] - mx) * LOG2E); sc[m] = p; l += p; }
            const float inv = 1.0f / l;
            for (int d8 = 0; d8 < 8; ++d8) {
                float o[8];
#pragma unroll
                for (int e = 0; e < 8; ++e) o[e] = 0.f;
                for (int m = 0; m <= i; ++m) { const float p = sc[m]; const u32x4 vw = *(const u32x4*)(Vb + (size_t)(MSEQ + m) * KVW + kh * 64 + d8 * 8);
#pragma unroll
                    for (int e = 0; e < 4; ++e) { o[2 * e] += p * bflo(vw[e]); o[2 * e + 1] += p * bfhi(vw[e]); } }
                u32x4 w; w.x = cvt_pk_bf16(o[0] * inv, o[1] * inv); w.y = cvt_pk_bf16(o[2] * inv, o[3] * inv); w.z = cvt_pk_bf16(o[4] * inv, o[5] * inv); w.w = cvt_pk_bf16(o[6] * inv, o[7] * inv);
                *(u32x4*)(YA + (size_t)(MSEQ + i) * AW + h * 64 + d8 * 8) = w;
            }
        }
        __syncthreads();
    }
}

__device__ __forceinline__ void sincos_acc(float x, float& sn, float& cs) {
    const float k = rintf(x * 0.636619772367581f);
    float r = fmaf(-k, 1.5703125f, x); r = fmaf(-k, 4.837512969970703125e-4f, r); r = fmaf(-k, 7.54978995489188216e-8f, r);
    const float r2 = r * r;
    const float sp = r + r * r2 * (-1.6666654611e-1f + r2 * (8.3321608736e-3f + r2 * (-1.9515295891e-4f)));
    const float cp = 1.0f - 0.5f * r2 + r2 * r2 * (4.166664568298827e-2f + r2 * (-1.388731625493765e-3f + r2 * 2.443315711809948e-5f));
    const int q = ((int)k) & 3;
    sn = (q == 0) ? sp : (q == 1) ? cp : (q == 2) ? -sp : -cp;
    cs = (q == 0) ? cp : (q == 1) ? -sp : (q == 2) ? -cp : sp;
}

template <int PASS>
__device__ __forceinline__ void ssm_phase(const Args& a, int l, const bf16_t* U, bf16_t* Y, f32x2* SC, LAS unsigned char* lds, int wave, int lane, int bid) {
    const float* lam_re = a.in[8] + l * 4096; const float* lam_im = a.in[9] + l * 4096; const float* lstep = a.in[10] + l * 64;
    const float* b_re = a.in[11] + (size_t)l * 65536; const float* b_im = a.in[12] + (size_t)l * 65536;
    const float* c_re = a.in[13] + (size_t)l * 65536; const float* c_im = a.in[14] + (size_t)l * 65536; const float* dsk = a.in[15] + l * 1024;
    constexpr int NCH = (PASS == 1) ? 31 : 32;
    const int fr = lane & 15, quad = lane >> 4;
    LAS unsigned char* Hw = lds + wave * (16 * 272);
    for (int id = bid * 8 + wave; id < NB * 64 * NCH; id += gridDim.x * 8) {
        const int g = id & 63, c = (id >> 6) % NCH, b = id / (64 * NCH);
        const float lr = lam_re[g * 64 + lane], li = lam_im[g * 64 + lane], dt = expf(lstep[g]);
        const float decay = expf(lr * dt); float sn, cs; sincos_acc(li * dt, sn, cs);
        const float ar = decay * cs, ai = decay * sn;
        const float den = lr * lr + li * li, nr = ar - 1.0f, ni = ai;
        const float zr = (nr * lr + ni * li) / den, zi = (ni * lr - nr * li) / den;
        float bre[16], bim[16];
#pragma unroll
        for (int p4 = 0; p4 < 4; ++p4) { const f32x4 br = *(const f32x4*)(b_re + (size_t)(g * 64 + lane) * 16 + p4 * 4), bi = *(const f32x4*)(b_im + (size_t)(g * 64 + lane) * 16 + p4 * 4);
#pragma unroll
            for (int e = 0; e < 4; ++e) { bre[p4 * 4 + e] = zr * br[e] - zi * bi[e]; bim[p4 * 4 + e] = zr * bi[e] + zi * br[e]; } }
        bf16x8 cf[4]; float dskp = 0.f;
        if (PASS == 2) {
#pragma unroll
            for (int ks = 0; ks < 4; ++ks) { const f32x4 cr = *(const f32x4*)(c_re + (size_t)(g * 16 + fr) * 64 + ks * 16 + quad * 4), ci = *(const f32x4*)(c_im + (size_t)(g * 16 + fr) * 64 + ks * 16 + quad * 4);
                u32x4 w; w.x = cvt_pk_bf16(cr[0], -ci[0]); w.y = cvt_pk_bf16(cr[1], -ci[1]); w.z = cvt_pk_bf16(cr[2], -ci[2]); w.w = cvt_pk_bf16(cr[3], -ci[3]);
                cf[ks] = __builtin_bit_cast(bf16x8, w); }
            dskp = dsk[g * 16 + fr];
        }
        float hr = 0.f, hi = 0.f;
        if (PASS == 2 && c > 0) {
            float pr = ar, pi = ai;
#pragma unroll
            for (int q = 0; q < 7; ++q) { const float t = pr * pr - pi * pi; pi = 2.0f * pr * pi; pr = t; }
            const f32x2* sc = SC + ((size_t)(b * 64 + g) * 32) * 64 + lane;
            const f32x2 s0 = sc[0]; hr = s0.x; hi = s0.y;
            for (int cc = 1; cc < c; ++cc) { const f32x2 sv = sc[cc * 64]; const float t = pr * hr - pi * hi + sv.x; hi = pr * hi + pi * hr + sv.y; hr = t; }
        }
        const int nblk = (c == 0) ? 9 : 8;
#define SSM_ROWBASE(k) ((c == 0) ? ((k) == 0 ? MSEQ : b * SEQ + ((k) - 1) * 16) : b * SEQ + c * 128 + (k) * 16)
        u32x4 v = *(const u32x4*)(U + (size_t)(SSM_ROWBASE(0) + ((lane & 31) >> 1)) * SW + g * 16 + (lane & 1) * 8);
        for (int k = 0; k < nblk; ++k) {
            const int rb = SSM_ROWBASE(k);
            u32x4 vn = v;
            if (k + 1 < nblk) vn = *(const u32x4*)(U + (size_t)(SSM_ROWBASE(k + 1) + ((lane & 31) >> 1)) * SW + g * 16 + (lane & 1) * 8);
#pragma unroll 2
            for (int tt = 0; tt < 16; ++tt) {
                unsigned w[8];
#pragma unroll
                for (int d = 0; d < 4; ++d) { w[d] = (unsigned)__builtin_amdgcn_readlane((int)v[d], 2 * tt); w[4 + d] = (unsigned)__builtin_amdgcn_readlane((int)v[d], 2 * tt + 1); }
                float xr = 0.f, xi = 0.f;
#pragma unroll
                for (int d = 0; d < 8; ++d) { const float u0 = bflo(w[d]), u1 = bfhi(w[d]);
                    xr = fmaf(bre[2 * d], u0, xr); xi = fmaf(bim[2 * d], u0, xi); xr = fmaf(bre[2 * d + 1], u1, xr); xi = fmaf(bim[2 * d + 1], u1, xi); }
                const float nhr = fmaf(ar, hr, fmaf(-ai, hi, xr)), nhi = fmaf(ar, hi, fmaf(ai, hr, xi));
                hr = nhr; hi = nhi;
                if (PASS == 2) *(LAS unsigned*)(Hw + tt * 272 + lane * 4) = cvt_pk_bf16(hr, hi);
            }
            if (PASS == 2) {
                const bool wr_ok = (rb < MSEQ) || (b == 0);
                asm volatile("s_waitcnt lgkmcnt(0)" ::: "memory");
                f32x4 acc = {0.f, 0.f, 0.f, 0.f};
#pragma unroll
                for (int ks = 0; ks < 4; ++ks) { const bf16x8 af = *(const LAS bf16x8*)(Hw + fr * 272 + ks * 64 + quad * 16); acc = __builtin_amdgcn_mfma_f32_16x16x32_bf16(af, cf[ks], acc, 0, 0, 0); }
#pragma unroll
                for (int j = 0; j < 4; ++j) { const size_t row = (size_t)(rb + quad * 4 + j);
                    const float uu = bf2f(U[row * SW + g * 16 + fr]);
                    const float y = acc[j] + dskp * uu;
                    const float z2 = 1.5957691216f * (y + 0.044715f * y * y * y);
                    const float gy = y * __builtin_amdgcn_rcpf(1.0f + __builtin_amdgcn_exp2f(-z2 * LOG2E));
                    if (wr_ok) Y[row * SW + g * 16 + fr] = (bf16_t)(cvt_pk_bf16(gy, gy) & 0xffffu); }
                asm volatile("s_waitcnt lgkmcnt(0)" ::: "memory");
            }
            v = vn;
        }
#undef SSM_ROWBASE
        if (PASS == 1) SC[((size_t)(b * 64 + g) * 32 + c) * 64 + lane] = (f32x2){hr, hi};
    }
}

__device__ __forceinline__ void skinny_gemm(const pg8::Gemm& g, const pg8::EpiAll& E, LAS unsigned char* lds, int tid, int wave, int lane, int bid) {
    const int fr = lane & 15, quad = lane >> 4, K = g.K, kw = K >> 3;
    LAS f32x4* red = (LAS f32x4*)lds;
    for (int task = bid; task < (g.N >> 4); task += gridDim.x) {
        const int n0 = task << 4;
        const bf16_t* ap = g.A + (size_t)(MSEQ + fr) * K + wave * kw + quad * 8;
        const bf16_t* bp = g.Bt + (size_t)(n0 + fr) * K + wave * kw + quad * 8;
        f32x4 acc = {0.f, 0.f, 0.f, 0.f};
#pragma unroll 4
        for (int k = 0; k < kw; k += 32) { const bf16x8 af = *(const bf16x8*)(ap + k), bf = *(const bf16x8*)(bp + k); acc = __builtin_amdgcn_mfma_f32_16x16x32_bf16(af, bf, acc, 0, 0, 0); }
        red[wave * 64 + lane] = acc;
        __syncthreads();
        if (wave == 0) {
            f32x4 s = red[lane];
#pragma unroll
            for (int w = 1; w < 8; ++w) s = s + red[w * 64 + lane];
            const int col = n0 + fr;
#pragma unroll
            for (int j = 0; j < 4; ++j) {
                const size_t row = (size_t)(MSEQ + quad * 4 + j); float v = s[j];
                if (E.mode == 5) { float* p = E.H + row * D + col; *p = *p * DN_ALPHA + v; }
                else {
                    bf16_t* op;
                    if (E.mode == 0) {
                        if (col < 1024) op = E.Q + row * AW + col;
                        else if (col < 1280) op = E.Kb + row * KVW + (col - 1024);
                        else if (col < 1536) op = E.Vb + row * KVW + (col - 1280);
                        else if (col < 2560) op = E.U + row * SW + (col - 1536);
                        else { op = E.G + row * 4096 + (col - 2560); v = sigmoid_f(v + E.gb[col - 2560]); }
                    } else {
                        op = E.O + row * E.ldc + col;
                        if (E.mode == 4) { v = fmaxf(v, 0.f); v = v * v; }
                        else { const float x = bf2f(E.X[row * E.ldx + col]);
                            if (E.mode == 1) v = x * sigmoid_f(v); else { v = v * x; if (E.mode == 3) v += bf2f(*op); } }
                    }
                    *op = (bf16_t)(cvt_pk_bf16(v, v) & 0xffffu);
                }
            }
        }
        __syncthreads();
    }
}

constexpr int NPHASE = 1 + 2 * 11;
__global__ void __launch_bounds__(512, 2) fwd_kernel(Args a) {
    extern __shared__ __attribute__((aligned(16))) unsigned char lds_raw[];
    LAS unsigned char* lds = (LAS unsigned char*)lds_raw;
    cg::grid_group grid = cg::this_grid();
    for (int ph = a.ph_lo; ph < a.ph_hi; ++ph) {
        int tid = threadIdx.x, bid = blockIdx.x;
        asm volatile("" : "+v"(tid)); asm volatile("" : "+s"(bid));
        const int lane = tid & 63, wave = __builtin_amdgcn_readfirstlane(tid >> 6);
        unsigned char* ws = a.ws;
        float* H32 = (float*)(ws + OFF_H32);
        bf16_t* HB = (bf16_t*)(ws + OFF_HB);
        unsigned char* pool = ws + OFF_POOL;
        bf16_t* Qb = (bf16_t*)(pool + PO_Q); bf16_t* Kb = (bf16_t*)(pool + PO_K); bf16_t* Vb = (bf16_t*)(pool + PO_V); bf16_t* Ub = (bf16_t*)(pool + PO_U);
        bf16_t* Gb = (bf16_t*)(pool + PO_G); bf16_t* YA = (bf16_t*)(pool + PO_YA);
        bf16_t* YS = HB;
        bf16_t* YG = Ub;
        bf16_t* F1 = (bf16_t*)pool;
        unsigned char* wt = ws + OFF_WT;
        f32x2* SC = (f32x2*)(ws + OFF_SC);
        const int l = (ph - 1) / 11, kind = (ph == 0) ? -1 : (ph - 1) % 11;
        bool is_gemm = false; pg8::Gemm g{nullptr, nullptr, MPAD, 0, 0}; pg8::EpiAll E{};
        if (kind == 0 && EN(0)) { is_gemm = true; g = pg8::Gemm{HB, (const bf16_t*)(wt + WA_IN), MPAD, INW, D};
            E.mode = 0; E.Q = Qb; E.Kb = Kb; E.Vb = Vb; E.U = Ub; E.G = Gb; E.gb = a.in[6] + (size_t)l * 4096; }
        else if (kind == 3 && EN(3)) { is_gemm = true; g = pg8::Gemm{YS, (const bf16_t*)(wt + WA_GLU), MPAD, SW, SW}; E.mode = 1; E.O = YG; E.ldc = SW; E.X = YS; E.ldx = SW; }
        else if (kind == 4 && EN(4)) { is_gemm = true; g = pg8::Gemm{YA, (const bf16_t*)(wt + WA_AU), MPAD, D, AW}; E.mode = 2; E.O = HB; E.ldc = D; E.X = Gb; E.ldx = 4096; }
        else if (kind == 5 && EN(4)) { is_gemm = true; g = pg8::Gemm{YG, (const bf16_t*)(wt + WA_SU), MPAD, D, SW}; E.mode = 3; E.O = HB; E.ldc = D; E.X = Gb + 2048; E.ldx = 4096; }
        else if (kind == 6 && EN(5)) { is_gemm = true; g = pg8::Gemm{HB, (const bf16_t*)(wt + WA_OUT), MPAD, D, D}; E.mode = 5; E.H = H32; }
        else if (kind == 8 && EN(7)) { is_gemm = true; g = pg8::Gemm{HB, (const bf16_t*)(wt + WB_UP), MPAD, DFF, D}; E.mode = 4; E.O = F1; E.ldc = DFF; }
        else if (kind == 9 && EN(8)) { is_gemm = true; g = pg8::Gemm{F1, (const bf16_t*)(wt + WB_DN), MPAD, D, DFF}; E.mode = 5; E.H = H32; }
        if (is_gemm) {
            pg8::StaticOrder S; S.init(MSEQ, g.N, (int)gridDim.x, bid);
            pg8::gemm_phase(lds, g, S, E, tid);
            skinny_gemm(g, E, lds, tid, wave, lane, bid);
        } else if (ph == 0 && EN(10)) {
            ln_phase<0>(a.in[0], a.in[1], a.in[2], a.in[3], H32, HB, nullptr, wave, lane, bid);
            convert_group_a(a, 0, wt, wave, lane, bid);
        } else if (kind == 1 && EN(1)) {
            attn_phase(Qb, Kb, Vb, YA, a.in[4], a.in[7] + l * 16, lds, tid, wave, lane, bid);
            ssm_phase<1>(a, l, Ub, YS, SC, lds, wave, lane, bid);
        } else if (kind == 2 && EN(2)) {
            ssm_phase<2>(a, l, Ub, YS, SC, lds, wave, lane, bid);
        } else if (kind == 7 && EN(6)) {
            ln_phase<1>(nullptr, nullptr, a.in[20] + l * D, a.in[21] + l * D, H32, HB, nullptr, wave, lane, bid);
            convert_group_b(a, l, wt, wave, lane, bid);
        } else if (kind == 10 && EN(9)) {
            if (l == 0) { ln_phase<1>(nullptr, nullptr, a.in[24], a.in[25], H32, HB, nullptr, wave, lane, bid); convert_group_a(a, 1, wt, wave, lane, bid); }
            else ln_phase<2>(nullptr, nullptr, a.in[24] + D, a.in[25] + D, H32, HB, a.out, wave, lane, bid);
        }
        if (ph + 1 < a.ph_hi && kind != 4) grid.sync();
    }
}

extern "C" void kernel_launch(void* const* d_in, const int* in_sizes, int n_in, void* d_out, int out_size, void* d_ws, size_t ws_size, hipStream_t stream) {
    static int grid = 0;
    if (grid == 0) {
        if (n_in != 26 || ws_size < WS_END) { fprintf(stderr, "kernel_launch: need 26 inputs and %zu bytes of workspace (got %d, %zu)\n", (size_t)WS_END, n_in, ws_size); grid = -1; return; }
        int dev = 0, cus = 0, per_cu = 0;
        (void)hipGetDevice(&dev);
        (void)hipDeviceGetAttribute(&cus, hipDeviceAttributeMultiprocessorCount, dev);
        if (hipFuncSetAttribute((const void*)fwd_kernel, hipFuncAttributeMaxDynamicSharedMemorySize, LDS_BYTES) != hipSuccess) { fprintf(stderr, "kernel_launch: hipFuncSetAttribute failed\n"); grid = -1; return; }
        if (hipOccupancyMaxActiveBlocksPerMultiprocessor(&per_cu, (const void*)fwd_kernel, 512, LDS_BYTES) != hipSuccess || per_cu < 1) { fprintf(stderr, "kernel_launch: occupancy query says %d\n", per_cu); per_cu = 1; }
        (void)hipGetLastError();
        grid = cus;
    }
    if (grid < 0) return;
    Args a{};
    for (int i = 0; i < 26; ++i) a.in[i] = (const float*)d_in[i];
    a.out = (float*)d_out; a.ws = (unsigned char*)d_ws; a.ph_lo = 0; a.ph_hi = NPHASE;
    void* args[] = {&a};
    hipError_t e = hipLaunchCooperativeKernel((const void*)fwd_kernel, dim3(grid), dim3(512), args, LDS_BYTES, stream);
    if (e != hipSuccess) fprintf(stderr, "kernel_launch: cooperative launch failed: %s (grid %d)\n", hipGetErrorString(e), grid);
}
```

```cpp
#include <hip/hip_runtime.h>
#include <hip/hip_cooperative_groups.h>
#include <cstdio>
namespace cg = cooperative_groups;

#define LAS __attribute__((address_space(3)))
typedef unsigned short bf16_t;
typedef short bf16x8 __attribute__((ext_vector_type(8)));
typedef float f32x4 __attribute__((ext_vector_type(4)));
typedef float f32x2 __attribute__((ext_vector_type(2)));
typedef unsigned u32x4 __attribute__((ext_vector_type(4)));
typedef unsigned u32x2 __attribute__((ext_vector_type(2)));

constexpr int D = 2048, NB = 4, SEQ = 4096, NMETA = 16;
constexpr int MSEQ = NB * SEQ;
constexpr int MROWS = MSEQ + NMETA;
constexpr int MPAD = MROWS;
constexpr int INW = 6656, DFF = 8192, AW = 1024, KVW = 256, SW = 1024;
constexpr float DN_ALPHA = 1.41421356237f;
constexpr float LOG2E = 1.44269504089f;

constexpr size_t OFF_H32 = 0;
constexpr size_t SZ_H32 = (size_t)MPAD * D * 4;
constexpr size_t OFF_HB = OFF_H32 + SZ_H32;
constexpr size_t SZ_HB = (size_t)MPAD * D * 2;
constexpr size_t OFF_POOL = OFF_HB + SZ_HB;
constexpr size_t SZ_POOL = (size_t)MPAD * DFF * 2;
constexpr size_t PO_Q = 0;
constexpr size_t PO_K = PO_Q + (size_t)MPAD * AW * 2;
constexpr size_t PO_V = PO_K + (size_t)MPAD * KVW * 2;
constexpr size_t PO_U = PO_V + (size_t)MPAD * KVW * 2;
constexpr size_t PO_G = PO_U + (size_t)MPAD * SW * 2;
constexpr size_t PO_YA = PO_G + (size_t)MPAD * 4096 * 2;
static_assert(PO_YA + (size_t)MPAD * AW * 2 <= SZ_POOL, "pool");
constexpr size_t OFF_WT = OFF_POOL + SZ_POOL;
constexpr size_t SZ_WT = ((size_t)INW * D + (size_t)SW * SW + 2 * (size_t)SW * D + (size_t)D * D) * 2 + (size_t)2 * D * DFF * 2;
constexpr size_t WA_IN = 0;
constexpr size_t WA_GLU = WA_IN + (size_t)INW * D * 2;
constexpr size_t WA_AU = WA_GLU + (size_t)SW * SW * 2;
constexpr size_t WA_SU = WA_AU + (size_t)AW * D * 2;
constexpr size_t WA_OUT = WA_SU + (size_t)SW * D * 2;
constexpr size_t WB_UP = WA_OUT + (size_t)D * D * 2;
constexpr size_t WB_DN = WB_UP + (size_t)D * DFF * 2;
static_assert(WB_DN + (size_t)D * DFF * 2 == SZ_WT, "wt");
constexpr size_t OFF_SC = OFF_WT + SZ_WT;
constexpr size_t SZ_SC = (size_t)NB * 64 * 32 * 64 * 8;
constexpr size_t OFF_AR = OFF_SC + SZ_SC;
constexpr size_t SZ_AR = (size_t)2 * 64 * 64 * 8;
constexpr size_t OFF_BB = OFF_AR + SZ_AR;
constexpr size_t SZ_BB = (size_t)2 * 64 * 128 * 16 * 2;
constexpr size_t OFF_BAR = OFF_BB + SZ_BB;
constexpr size_t SZ_BAR = 1024;
constexpr size_t WS_END = OFF_BAR + SZ_BAR;

constexpr int LDS_BYTES = 140864;
#ifndef ONLY
#define ONLY -1
#endif
#ifndef MASK
#define MASK 0xFFFF
#endif
#ifndef PROBE_MASK
#define PROBE_MASK 0
#endif
#define EN(k) (((MASK) >> (k)) & 1)

struct Args { const float* in[26]; float* out; unsigned char* ws; int ph_lo, ph_hi; };

__device__ __forceinline__ unsigned cvt_pk_bf16(float lo, float hi) { unsigned r; asm volatile("v_cvt_pk_bf16_f32 %0, %1, %2" : "=v"(r) : "v"(lo), "v"(hi)); return r; }
__device__ __forceinline__ float bflo(unsigned w) { return __uint_as_float(w << 16); }
__device__ __forceinline__ float bfhi(unsigned w) { return __uint_as_float(w & 0xffff0000u); }
__device__ __forceinline__ float bf2f(bf16_t v) { return __uint_as_float(((unsigned)v) << 16); }
__device__ __forceinline__ float sigmoid_f(float x) { return __builtin_amdgcn_rcpf(1.0f + __builtin_amdgcn_exp2f(-x * LOG2E)); }
template <int CTRL> __device__ __forceinline__ float dpp_f(float v) { return __int_as_float(__builtin_amdgcn_update_dpp(0, __float_as_int(v), CTRL, 0xf, 0xf, true)); }
__device__ __forceinline__ float row16_max(float v) { v = fmaxf(v, dpp_f<0xB1>(v)); v = fmaxf(v, dpp_f<0x4E>(v)); v = fmaxf(v, dpp_f<0x141>(v)); v = fmaxf(v, dpp_f<0x140>(v)); return v; }
__device__ __forceinline__ float row16_sum(float v) { v += dpp_f<0xB1>(v); v += dpp_f<0x4E>(v); v += dpp_f<0x141>(v); v += dpp_f<0x140>(v); return v; }
__device__ __forceinline__ float wave_sum(float v) { for (int o = 32; o > 0; o >>= 1) v += __shfl_xor(v, o); return v; }
__device__ __forceinline__ int t5_bucket(int n) {
    if (n < 16) return n;
    return 16 + (n >= 19) + (n >= 21) + (n >= 24) + (n >= 27) + (n >= 31) + (n >= 35) + (n >= 40) + (n >= 46) + (n >= 52) + (n >= 59) + (n >= 67) + (n >= 77) + (n >= 87) + (n >= 99) + (n >= 113);
}

namespace pg8 {
constexpr int BM = 256, BK = 64, HALF = 128, HTB = HALF * BK * 2, STAGE_BYTES = 8 * HTB, NXCD = 8, WGM = 4;
__device__ __forceinline__ int lds_byte(int r, int c) { const int st = (r >> 4) * 2 + (c >> 5), rr = r & 15, cc = c & 31, ob = rr * 64 + cc * 2; return st * 1024 + (ob ^ (((ob >> 9) & 1) << 5)); }
__device__ __forceinline__ void stage_rc(int b, int& R, int& C) { const int st = b / 1024, sb = b % 1024, swz = sb ^ (((sb >> 9) & 1) << 5); R = (st >> 1) * 16 + swz / 64; C = (st & 1) * 32 + (swz % 64) / 2; }
__device__ __forceinline__ int perm32(int rho) { const int n = rho >> 4, i = rho & 15; return 8 * (i >> 2) + 4 * n + (i & 3); }
struct Unit { int pm, pn; };
struct Gemm { const bf16_t* A; const bf16_t* Bt; int M, N, K; };
struct StaticOrder {
    int nM, nN, nwg, G, c, rev;
    __device__ void init(int M, int N, int G_, int c_, int rev_ = 0) { nM = M / BM; nN = N / BM; nwg = nM * nN; G = G_; c = c_; rev = (rev_ && nwg % G_ == 0) ? nwg / G_ : 0; }
    __device__ bool next(int i, Unit& u) const {
        if (rev && i >= rev) return false;
        const long L = (long)(rev ? rev - 1 - i : i) * G + c; if (L >= nwg) return false;
        int wgid = (int)L; { const int q = nwg / NXCD, r = nwg % NXCD, xcd = wgid % NXCD, off = wgid / NXCD; wgid = (xcd < r ? xcd * (q + 1) : r * (q + 1) + (xcd - r) * q) + off; }
        const int nig = WGM * nN, gid = wgid / nig, fm = gid * WGM, gsz = (nM - fm) < WGM ? (nM - fm) : WGM;
        u.pm = fm + ((wgid % nig) % gsz); u.pn = (wgid % nig) / gsz; return true;
    }
};
template <class Epi>
__device__ __forceinline__ void gemm_phase(LAS unsigned char* lds, const Gemm g, const StaticOrder& S, const Epi& E, const int tid) {
    const int wid = __builtin_amdgcn_readfirstlane(tid >> 6), lane = tid & 63, wr = wid >> 2, wc = wid & 3, fr = lane & 15, fq = lane >> 4;
    const int K = g.K, nt = K / BK;
    unsigned voffA[2], voffB[2];
#pragma unroll
    for (int i = 0; i < 2; ++i) { int R, C; stage_rc(tid * 16 + i * 8192, R, C); const int Rb = E.perm() ? ((R & ~31) + perm32(R & 31)) : R;
        voffA[i] = (unsigned)(R * K + C) * 2u; voffB[i] = (unsigned)(Rb * K + C) * 2u; }
    const size_t kstep = (size_t)(BK * 2);
    const size_t hstep = (size_t)HALF * K * 2;
    const size_t tstep = 2 * hstep;
    const unsigned ldsw = (unsigned)wid * 1024u;
    const int aoff = lds_byte(wr * 64 + fr, fq * 8), boff = lds_byte(wc * 32 + fr, fq * 8);
#define PG8_SA(b, h) (((b) * 2 + (h)) * HTB)
#define PG8_SB(b, h) ((4 + (b) * 2 + (h)) * HTB)
#define PG8_STAGE(bufoff, gbase, voff) do { _Pragma("unroll") for (int _i = 0; _i < 2; ++_i) \
        __builtin_amdgcn_global_load_lds((const unsigned*)((const char*)(gbase) + (voff)[_i]), (LAS unsigned*)(lds + (bufoff) + ldsw + _i * 8192), 16, 0, 0); } while (0)
#define PG8_LDA(dst, b, h) do { _Pragma("unroll") for (int m = 0; m < 4; ++m) _Pragma("unroll") for (int k = 0; k < 2; ++k) dst[m][k] = *(const LAS bf16x8*)(lds + PG8_SA(b, h) + aoff + m * 2048 + k * 1024); } while (0)
#define PG8_LDB(dst, b, h) do { _Pragma("unroll") for (int n = 0; n < 2; ++n) _Pragma("unroll") for (int k = 0; k < 2; ++k) dst[n][k] = *(const LAS bf16x8*)(lds + PG8_SB(b, h) + boff + n * 2048 + k * 1024); } while (0)
#define PG8_MMA(ai, bj, At, Bt) do { __builtin_amdgcn_s_setprio(1); _Pragma("unroll") for (int m = 0; m < 4; ++m) _Pragma("unroll") for (int n = 0; n < 2; ++n) _Pragma("unroll") for (int k = 0; k < 2; ++k) \
        acc[ai][bj][m][n] = __builtin_amdgcn_mfma_f32_16x16x32_bf16(Bt[n][k], At[m][k], acc[ai][bj][m][n], 0, 0, 0); __builtin_amdgcn_s_setprio(0); } while (0)
#define PG8_WAIT_V(n) asm volatile("s_waitcnt vmcnt(" #n ")" ::: "memory")
#define PG8_WAIT_L(n) asm volatile("s_waitcnt lgkmcnt(" #n ")" ::: "memory")
#define PG8_BAR __builtin_amdgcn_s_barrier()
#define PG8_SCHED __builtin_amdgcn_sched_barrier(0)
    Unit cur, nxt; int ui = 0;
    if (!S.next(0, cur)) return;
    f32x4 acc[2][2][4][2];
#pragma unroll
    for (int a = 0; a < 2; ++a)
#pragma unroll
        for (int b = 0; b < 2; ++b)
#pragma unroll
            for (int m = 0; m < 4; ++m)
#pragma unroll
                for (int n = 0; n < 2; ++n) acc[a][b][m][n] = (f32x4){0.f, 0.f, 0.f, 0.f};
    bf16x8 At[4][2], B0[2][2], B1[2][2];
    const char* cA = (const char*)g.A + (size_t)cur.pm * tstep; const char* cB = (const char*)g.Bt + (size_t)cur.pn * tstep;
    PG8_STAGE(PG8_SB(0, 0), cB, voffB); PG8_STAGE(PG8_SA(0, 0), cA, voffA); PG8_STAGE(PG8_SB(0, 1), cB + hstep, voffB); PG8_STAGE(PG8_SA(0, 1), cA + hstep, voffA);
    if (wr == 1) PG8_BAR;
    PG8_WAIT_V(4); PG8_BAR;
    PG8_STAGE(PG8_SB(1, 0), cB + kstep, voffB); PG8_STAGE(PG8_SA(1, 0), cA + kstep, voffA); PG8_STAGE(PG8_SB(1, 1), cB + hstep + kstep, voffB);
    PG8_WAIT_V(6); PG8_BAR;
    for (;;) {
        const bool has_next = S.next(ui + 1, nxt);
        const char* nA = has_next ? (const char*)g.A + (size_t)nxt.pm * tstep : cA; const char* nB = has_next ? (const char*)g.Bt + (size_t)nxt.pn * tstep : cB;
        for (int t = 0; t < nt; t += 2) {
            const bool last = (t == nt - 2);
            const char* a1 = cA + (size_t)(t + 1) * kstep;
            const char* a2 = last ? nA : cA + (size_t)(t + 2) * kstep; const char* b2 = last ? nB : cB + (size_t)(t + 2) * kstep;
            const char* a3 = a2 + kstep; const char* b3 = b2 + kstep;
            PG8_LDB(B0, 0, 0); PG8_SCHED; PG8_LDA(At, 0, 0); PG8_STAGE(PG8_SA(1, 1), a1 + hstep, voffA);
            PG8_WAIT_L(8); PG8_BAR; PG8_WAIT_L(0); PG8_MMA(0, 0, At, B0); PG8_BAR; PG8_SCHED;
            PG8_LDB(B1, 0, 1); PG8_STAGE(PG8_SB(0, 0), b2, voffB);
            PG8_BAR; PG8_WAIT_L(0); PG8_MMA(0, 1, At, B1); PG8_BAR;
            PG8_LDA(At, 0, 1); PG8_STAGE(PG8_SA(0, 0), a2, voffA);
            PG8_BAR; PG8_WAIT_L(0); PG8_MMA(1, 0, At, B0); PG8_BAR; PG8_SCHED;
            PG8_STAGE(PG8_SB(0, 1), b2 + hstep, voffB);
            PG8_WAIT_V(6); PG8_BAR; PG8_MMA(1, 1, At, B1); PG8_BAR;
            PG8_LDB(B0, 1, 0); PG8_SCHED; PG8_LDA(At, 1, 0); PG8_STAGE(PG8_SA(0, 1), a2 + hstep, voffA);
            PG8_WAIT_L(8); PG8_BAR; PG8_WAIT_L(0); PG8_MMA(0, 0, At, B0); PG8_BAR; PG8_SCHED;
            PG8_LDB(B1, 1, 1); PG8_STAGE(PG8_SB(1, 0), b3, voffB);
            PG8_BAR; PG8_WAIT_L(0); PG8_MMA(0, 1, At, B1); PG8_BAR;
            PG8_LDA(At, 1, 1); PG8_STAGE(PG8_SA(1, 0), a3, voffA);
            PG8_BAR; PG8_WAIT_L(0); PG8_MMA(1, 0, At, B0); PG8_BAR; PG8_SCHED;
            PG8_STAGE(PG8_SB(1, 1), b3 + hstep, voffB);
            PG8_WAIT_V(6); PG8_BAR; PG8_MMA(1, 1, At, B1); PG8_BAR;
        }
        E(acc, cur, wr, wc, fr, fq);
        if (!has_next) break;
#pragma unroll
        for (int a = 0; a < 2; ++a)
#pragma unroll
            for (int b = 0; b < 2; ++b)
#pragma unroll
                for (int m = 0; m < 4; ++m)
#pragma unroll
                    for (int n = 0; n < 2; ++n) acc[a][b][m][n] = (f32x4){0.f, 0.f, 0.f, 0.f};
        cur = nxt; cA = nA; cB = nB; ++ui;
    }
    PG8_WAIT_V(0);
    if (wr == 0) PG8_BAR;
    PG8_BAR;
#undef PG8_SA
#undef PG8_SB
#undef PG8_STAGE
#undef PG8_LDA
#undef PG8_LDB
#undef PG8_MMA
#undef PG8_WAIT_V
#undef PG8_WAIT_L
#undef PG8_BAR
#undef PG8_SCHED
}

typedef f32x4 Acc[2][2][4][2];
struct EpiAll {
    int mode;
    bf16_t* O; int ldc; const bf16_t* X; int ldx; float* H;
    bf16_t *Q, *Kb, *Vb, *U, *G; const float* gb;
    __device__ __forceinline__ bool perm() const { return mode != 5; }
    __device__ __forceinline__ void operator()(const Acc& acc, const Unit& u, int wr, int wc, int fr, int fq) const {
        if (mode == 5) {
            const int row0 = u.pm * BM + wr * 64 + fr, col0 = u.pn * BM + wc * 32 + 4 * fq;
            u32x2 hw[2][4][2][2];
#pragma unroll
            for (int ai = 0; ai < 2; ++ai)
#pragma unroll
                for (int m = 0; m < 4; ++m) { const bf16_t* hbp = X + (size_t)(row0 + ai * HALF + m * 16) * D + col0;
#pragma unroll
                    for (int bj = 0; bj < 2; ++bj)
#pragma unroll
                        for (int n = 0; n < 2; ++n) hw[ai][m][bj][n] = *(const u32x2*)(hbp + bj * HALF + n * 16); }
            asm volatile("" ::: "memory");
#pragma unroll
            for (int ai = 0; ai < 2; ++ai)
#pragma unroll
                for (int m = 0; m < 4; ++m) { float* rowp = H + (size_t)(row0 + ai * HALF + m * 16) * D + col0;
#pragma unroll
                    for (int bj = 0; bj < 2; ++bj)
#pragma unroll
                        for (int n = 0; n < 2; ++n) { const u32x2 w = hw[ai][m][bj][n]; const f32x4 h = {bflo(w.x), bfhi(w.x), bflo(w.y), bfhi(w.y)}; *(f32x4*)(rowp + bj * HALF + n * 16) = h * DN_ALPHA + acc[ai][bj][m][n]; } }
            return;
        }
        bf16_t* base = O; int ld = ldc, colt = u.pn * BM; bool gate = false;
        if (mode == 0) { const int pn = u.pn;
            if (pn < 4) { base = Q; ld = AW; colt = pn * 256; }
            else if (pn == 4) { base = Kb; ld = KVW; colt = 0; }
            else if (pn == 5) { base = Vb; ld = KVW; colt = 0; }
            else if (pn < 10) { base = U; ld = SW; colt = (pn - 6) * 256; }
            else { base = G; ld = 4096; colt = (pn - 10) * 256; gate = true; } }
        const int row0 = u.pm * BM + wr * 64 + fr, col0 = colt + wc * 32 + 8 * fq;
        f32x4 bv[2][2];
#pragma unroll
        for (int bj = 0; bj < 2; ++bj)
#pragma unroll
            for (int n = 0; n < 2; ++n) bv[bj][n] = gate ? *(const f32x4*)(gb + col0 + bj * HALF + 4 * n) : (f32x4){0.f, 0.f, 0.f, 0.f};
        const bool need_x = (mode >= 1 && mode <= 3), need_o = (mode == 3);
#pragma unroll
        for (int ai = 0; ai < 2; ++ai)
#pragma unroll
        for (int mh = 0; mh < 2; ++mh) {
            u32x4 xw[2][2], ow[2][2];
#pragma unroll
            for (int mm = 0; mm < 2; ++mm)
#pragma unroll
                for (int bj = 0; bj < 2; ++bj) { const size_t r = (size_t)(row0 + ai * HALF + (mh * 2 + mm) * 16);
                    xw[mm][bj] = (u32x4){0u, 0u, 0u, 0u}; ow[mm][bj] = (u32x4){0u, 0u, 0u, 0u};
                    if (need_x) xw[mm][bj] = *(const u32x4*)(X + r * ldx + col0 + bj * HALF);
                    if (need_o) ow[mm][bj] = *(const u32x4*)(base + r * ld + col0 + bj * HALF); }
            asm volatile("" ::: "memory");
#pragma unroll
            for (int mm = 0; mm < 2; ++mm) { const int m = mh * 2 + mm; const size_t r = (size_t)(row0 + ai * HALF + m * 16);
#pragma unroll
                for (int bj = 0; bj < 2; ++bj) { f32x4 v0 = acc[ai][bj][m][0] + bv[bj][0], v1 = acc[ai][bj][m][1] + bv[bj][1];
                    bf16_t* op = base + r * ld + col0 + bj * HALF;
                    if (mode == 0) {
                        if (gate) {
#pragma unroll
                            for (int j = 0; j < 4; ++j) { v0[j] = sigmoid_f(v0[j]); v1[j] = sigmoid_f(v1[j]); } }
                    } else if (mode == 4) {
#pragma unroll
                        for (int j = 0; j < 4; ++j) { const float a0 = fmaxf(v0[j], 0.f), a1 = fmaxf(v1[j], 0.f); v0[j] = a0 * a0; v1[j] = a1 * a1; }
                    } else {
                        const u32x4 xv = xw[mm][bj];
                        const f32x4 x0 = {bflo(xv.x), bfhi(xv.x), bflo(xv.y), bfhi(xv.y)}, x1 = {bflo(xv.z), bfhi(xv.z), bflo(xv.w), bfhi(xv.w)};
                        if (mode == 1) {
#pragma unroll
                            for (int j = 0; j < 4; ++j) { v0[j] = x0[j] * sigmoid_f(v0[j]); v1[j] = x1[j] * sigmoid_f(v1[j]); }
                        } else { v0 = v0 * x0; v1 = v1 * x1;
                            if (mode == 3) { const u32x4 ov = ow[mm][bj];
                                const f32x4 o0 = {bflo(ov.x), bfhi(ov.x), bflo(ov.y), bfhi(ov.y)}, o1 = {bflo(ov.z), bfhi(ov.z), bflo(ov.w), bfhi(ov.w)};
                                v0 = v0 + o0; v1 = v1 + o1; } }
                    }
                    u32x4 w; w.x = cvt_pk_bf16(v0[0], v0[1]); w.y = cvt_pk_bf16(v0[2], v0[3]); w.z = cvt_pk_bf16(v1[0], v1[1]); w.w = cvt_pk_bf16(v1[2], v1[3]);
                    *(u32x4*)op = w; } }
            asm volatile("" ::: "memory");
        }
    }
};
}

template <int MODE>
__device__ __forceinline__ void ln_phase(const float* x, const float* meta, const float* gam, const float* bet, float* H32, bf16_t* HB, float* out, int wave, int lane, int bid) {
    const int gw = bid * 8 + wave, nw = gridDim.x * 8;
    const int nrows = (MODE == 2) ? MSEQ : MPAD;
    f32x4 gv[8], bv[8];
#pragma unroll
    for (int i = 0; i < 8; ++i) { gv[i] = *(const f32x4*)(gam + i * 256 + lane * 4); bv[i] = *(const f32x4*)(bet + i * 256 + lane * 4); }
    for (int r = gw; r < nrows; r += nw) {
        const float* src;
        if (MODE == 0) src = (r < MSEQ) ? x + (size_t)r * D : meta + (size_t)(r - MSEQ) * D;
        else src = H32 + (size_t)r * D;
        f32x4 v[8];
        if (src) {
#pragma unroll
            for (int i = 0; i < 8; ++i) v[i] = *(const f32x4*)(src + i * 256 + lane * 4);
            float s = 0.f;
#pragma unroll
            for (int i = 0; i < 8; ++i) s += (v[i][0] + v[i][1]) + (v[i][2] + v[i][3]);
            const float mu = wave_sum(s) * (1.0f / D);
            float q = 0.f;
#pragma unroll
            for (int i = 0; i < 8; ++i) { v[i] = v[i] - mu; q += (v[i][0] * v[i][0] + v[i][1] * v[i][1]) + (v[i][2] * v[i][2] + v[i][3] * v[i][3]); }
            const float rstd = 1.0f / sqrtf(wave_sum(q) * (1.0f / D) + 1e-5f);
#pragma unroll
            for (int i = 0; i < 8; ++i) v[i] = v[i] * rstd * gv[i] + bv[i];
        } else {
#pragma unroll
            for (int i = 0; i < 8; ++i) v[i] = (f32x4){0.f, 0.f, 0.f, 0.f};
        }
        if (MODE == 2) {
#pragma unroll
            for (int i = 0; i < 8; ++i) *(f32x4*)(out + (size_t)r * D + i * 256 + lane * 4) = v[i];
        } else {
#pragma unroll
            for (int i = 0; i < 8; ++i) {
                u32x2 w; w.x = cvt_pk_bf16(v[i][0], v[i][1]); w.y = cvt_pk_bf16(v[i][2], v[i][3]); *(u32x2*)(HB + (size_t)r * D + i * 256 + lane * 4) = w; }
        }
    }
}

__device__ __forceinline__ void convert_wt(const float* __restrict__ W, bf16_t* __restrict__ Wt, int K, int N, int wave, int lane, int bid, int nblk) {
    const int tn = N / 64, ntile = tn * (K / 64);
    for (int t = bid * 8 + wave; t < ntile; t += nblk * 8) {
        const int k0 = (t / tn) * 64, n0 = (t % tn) * 64;
        const float* src = W + (size_t)k0 * N + n0 + lane;
        float f[64];
#pragma unroll
        for (int e = 0; e < 64; ++e) f[e] = src[(size_t)e * N];
        bf16_t* dst = Wt + (size_t)(n0 + lane) * K + k0;
#pragma unroll
        for (int kg = 0; kg < 8; ++kg) { u32x4 w; w.x = cvt_pk_bf16(f[kg * 8 + 0], f[kg * 8 + 1]); w.y = cvt_pk_bf16(f[kg * 8 + 2], f[kg * 8 + 3]); w.z = cvt_pk_bf16(f[kg * 8 + 4], f[kg * 8 + 5]); w.w = cvt_pk_bf16(f[kg * 8 + 6], f[kg * 8 + 7]);
            *(u32x4*)(dst + kg * 8) = w; }
    }
}
__device__ __forceinline__ void convert_group_a(const Args& a, int l, unsigned char* wt, int wave, int lane, int bid) {
    convert_wt(a.in[5] + (size_t)l * D * INW, (bf16_t*)(wt + WA_IN), D, INW, wave, lane, bid, (int)gridDim.x);
    convert_wt(a.in[16] + (size_t)l * SW * SW, (bf16_t*)(wt + WA_GLU), SW, SW, wave, lane, bid, (int)gridDim.x);
    convert_wt(a.in[17] + (size_t)l * AW * D, (bf16_t*)(wt + WA_AU), AW, D, wave, lane, bid, (int)gridDim.x);
    convert_wt(a.in[18] + (size_t)l * SW * D, (bf16_t*)(wt + WA_SU), SW, D, wave, lane, bid, (int)gridDim.x);
    convert_wt(a.in[19] + (size_t)l * D * D, (bf16_t*)(wt + WA_OUT), D, D, wave, lane, bid, (int)gridDim.x);
}
__device__ __forceinline__ void convert_mlp_up(const Args& a, int l, unsigned char* wt, int wave, int lane, int bid, int nblk) {
    convert_wt(a.in[22] + (size_t)l * D * DFF, (bf16_t*)(wt + WB_UP), D, DFF, wave, lane, bid, nblk);
}
__device__ __forceinline__ void convert_mlp_down(const Args& a, int l, unsigned char* wt, int wave, int lane, int bid, int nblk) {
    convert_wt(a.in[23] + (size_t)l * DFF * D, (bf16_t*)(wt + WB_DN), DFF, D, wave, lane, bid, nblk);
}

constexpr int AT_KSTR = 72, AT_VSTR = 296, AT_PSTR = 232;
constexpr int AT_K_OFF = 0, AT_V_OFF = 288 * AT_KSTR * 2, AT_P_OFF = AT_V_OFF + 64 * AT_VSTR * 2, AT_T_OFF = AT_P_OFF + 8 * 16 * AT_PSTR * 2, AT_END = AT_T_OFF + 4 * 132 * 4;
static_assert(AT_END <= LDS_BYTES, "attn lds");

__device__ __forceinline__ void attn_phase(const bf16_t* Qb, const bf16_t* Kb, const bf16_t* Vb, bf16_t* YA, const float* rel_bias, const float* sinks,
                                           LAS unsigned char* lds, int tid, int wave, int lane, int bid, bool meta_q) {
    LAS bf16_t* vt = (LAS bf16_t*)(lds + AT_V_OFF);
    LAS float* tab = (LAS float*)(lds + AT_T_OFF);
    const int fr = lane & 15, quad = lane >> 4;
    for (int it = bid; it < NB * 32 * 4; it += gridDim.x) {
        const int b = it >> 7, nb = (it >> 2) & 31, kh = it & 3;
        {
            u32x4 kvr[5], vvr[5];
#pragma unroll
            for (int i = 0; i < 5; ++i) { const int c = tid + i * 512; kvr[i] = (u32x4){0u, 0u, 0u, 0u}; vvr[i] = (u32x4){0u, 0u, 0u, 0u};
                if (c < 272 * 8) { const int kk = c >> 3, part = c & 7; int row; bool ok = true;
                    if (kk < 16) row = MSEQ + kk;
                    else if (kk < 144) { row = b * SEQ + nb * 128 - 128 + (kk - 16); ok = nb > 0; }
                    else row = b * SEQ + nb * 128 + (kk - 144);
                    if (ok) { kvr[i] = *(const u32x4*)(Kb + (size_t)row * KVW + kh * 64 + part * 8); vvr[i] = *(const u32x4*)(Vb + (size_t)row * KVW + kh * 64 + part * 8); } } }
#pragma unroll
            for (int i = 0; i < 5; ++i) { const int c = tid + i * 512;
                if (c < 272 * 8) { const int kk = c >> 3, part = c & 7, lr = kk < 16 ? kk : kk + 16;
                    *(LAS u32x4*)(lds + AT_K_OFF + (lr * AT_KSTR + part * 8) * 2) = kvr[i];
#pragma unroll
                    for (int e2 = 0; e2 < 8; ++e2) vt[(part * 8 + e2) * AT_VSTR + lr] = (bf16_t)(vvr[i][e2 >> 1] >> ((e2 & 1) * 16)); } }
        }
        for (int c = tid; c < 1024; c += 512) vt[(c >> 4) * AT_VSTR + 16 + (c & 15)] = 0;
        for (int c = tid; c < 4 * 129; c += 512) { const int g = c / 129, dd = c - g * 129; tab[g * 132 + dd] = rel_bias[t5_bucket(dd) * 16 + kh * 4 + g]; }
        __syncthreads();
        {
            const int g = wave >> 1, half = wave & 1, h = kh * 4 + g;
            const float sink = sinks[h];
            LAS bf16_t* Pw = (LAS bf16_t*)(lds + AT_P_OFF + wave * 16 * AT_PSTR * 2);
            for (int c = lane; c < 256; c += 64) Pw[(c >> 4) * AT_PSTR + 16 + (c & 15)] = 0;
            const bf16_t* qbase = Qb + (size_t)(b * SEQ + nb * 128 + half * 64 + fr) * AW + h * 64 + quad * 8;
            bf16x8 qn0 = *(const bf16x8*)qbase, qn1 = *(const bf16x8*)(qbase + 32);
            for (int rt = 0; rt < 4; ++rt) {
                const int iq0 = half * 64 + rt * 16;
                const bf16x8 qf0 = qn0, qf1 = qn1;
                if (rt < 3) { qn0 = *(const bf16x8*)(qbase + (size_t)(rt + 1) * 16 * AW); qn1 = *(const bf16x8*)(qbase + (size_t)(rt + 1) * 16 * AW + 32); }
                f32x4 s[13];
#define AT_KROW(kt) (((kt) == 0) ? 0 : 32 + 64 * half + ((kt) - 1) * 16)
                bf16x8 kc0 = *(const LAS bf16x8*)(lds + AT_K_OFF + ((AT_KROW(0) + fr) * AT_KSTR + quad * 8) * 2);
                bf16x8 kc1 = *(const LAS bf16x8*)(lds + AT_K_OFF + ((AT_KROW(0) + fr) * AT_KSTR + 32 + quad * 8) * 2);
#pragma unroll
                for (int kt = 0; kt < 13; ++kt) {
                    bf16x8 kn0 = kc0, kn1 = kc1;
                    if (kt < 12) { kn0 = *(const LAS bf16x8*)(lds + AT_K_OFF + ((AT_KROW(kt + 1) + fr) * AT_KSTR + quad * 8) * 2);
                                   kn1 = *(const LAS bf16x8*)(lds + AT_K_OFF + ((AT_KROW(kt + 1) + fr) * AT_KSTR + 32 + quad * 8) * 2); }
                    f32x4 z = {0.f, 0.f, 0.f, 0.f};
                    z = __builtin_amdgcn_mfma_f32_16x16x32_bf16(qf0, kc0, z, 0, 0, 0);
                    s[kt] = __builtin_amdgcn_mfma_f32_16x16x32_bf16(qf1, kc1, z, 0, 0, 0);
                    kc0 = kn0; kc1 = kn1;
                    __builtin_amdgcn_sched_barrier(0);
                }
#undef AT_KROW
                float mx[4] = {sink, sink, sink, sink};
#pragma unroll
                for (int kt = 0; kt < 13; ++kt)
#pragma unroll
                    for (int j = 0; j < 4; ++j) {
                        const int iq = iq0 + quad * 4 + j; float v;
                        if (kt == 0) { int dist = nb * 128 + iq + 16 - fr; dist = dist > 128 ? 128 : dist; v = s[kt][j] * 0.125f + tab[g * 132 + dist]; }
                        else { const int kkr = 64 * half + (kt - 1) * 16 + fr, dist = iq + 128 - kkr;
                            const bool valid = (dist >= 0) && (dist < 128) && (nb > 0 || kkr >= 128);
                            v = valid ? s[kt][j] * 0.125f + tab[g * 132 + (dist & 127)] : -1e30f; }
                        s[kt][j] = v; mx[j] = fmaxf(mx[j], v);
                    }
                float l[4];
#pragma unroll
                for (int j = 0; j < 4; ++j) { mx[j] = row16_max(mx[j]); l[j] = 0.f; }
#pragma unroll
                for (int kt = 0; kt < 13; ++kt) {
                    const int pcol = (kt == 0) ? fr : 32 + (kt - 1) * 16 + fr;
#pragma unroll
                    for (int j = 0; j < 4; ++j) { const float p = __builtin_amdgcn_exp2f((s[kt][j] - mx[j]) * LOG2E); l[j] += p;
                        Pw[(quad * 4 + j) * AT_PSTR + pcol] = (bf16_t)(cvt_pk_bf16(p, p) & 0xffffu); }
                }
#pragma unroll
                for (int j = 0; j < 4; ++j) { l[j] = row16_sum(l[j]) + __builtin_amdgcn_exp2f((sink - mx[j]) * LOG2E); l[j] = 1.0f / l[j]; }
                asm volatile("s_waitcnt lgkmcnt(0)" ::: "memory");
                f32x4 o[4];
#pragma unroll
                for (int dt = 0; dt < 4; ++dt) o[dt] = (f32x4){0.f, 0.f, 0.f, 0.f};
#define AT_CB(ks) (((ks) == 0) ? 0 : 32 + 64 * half + ((ks) - 1) * 32)
                bf16x8 pc = *(const LAS bf16x8*)(Pw + fr * AT_PSTR + quad * 8), vc[4];
#pragma unroll
                for (int dt = 0; dt < 4; ++dt) vc[dt] = *(const LAS bf16x8*)(vt + (dt * 16 + fr) * AT_VSTR + AT_CB(0) + quad * 8);
#pragma unroll
                for (int ks = 0; ks < 7; ++ks) {
                    bf16x8 pn = pc, vn[4];
#pragma unroll
                    for (int dt = 0; dt < 4; ++dt) vn[dt] = vc[dt];
                    if (ks < 6) { pn = *(const LAS bf16x8*)(Pw + fr * AT_PSTR + (ks + 1) * 32 + quad * 8);
#pragma unroll
                        for (int dt = 0; dt < 4; ++dt) vn[dt] = *(const LAS bf16x8*)(vt + (dt * 16 + fr) * AT_VSTR + AT_CB(ks + 1) + quad * 8); }
#pragma unroll
                    for (int dt = 0; dt < 4; ++dt) o[dt] = __builtin_amdgcn_mfma_f32_16x16x32_bf16(pc, vc[dt], o[dt], 0, 0, 0);
                    pc = pn;
#pragma unroll
                    for (int dt = 0; dt < 4; ++dt) vc[dt] = vn[dt];
                    __builtin_amdgcn_sched_barrier(0);
                }
#undef AT_CB
#pragma unroll
                for (int j = 0; j < 4; ++j) { const size_t orow = (size_t)(b * SEQ + nb * 128 + iq0 + quad * 4 + j);
#pragma unroll
                    for (int dt = 0; dt < 4; ++dt) { const float ov = o[dt][j] * l[j]; YA[orow * AW + h * 64 + dt * 16 + fr] = (bf16_t)(cvt_pk_bf16(ov, ov) & 0xffffu); } }
                asm volatile("s_waitcnt lgkmcnt(0)" ::: "memory");
            }
        }
        __syncthreads();
    }
    if (bid < 16 && meta_q && tid < 128) {
        const int h = bid, i = tid >> 3, d8 = tid & 7, kh = h >> 2;
        const float sink = sinks[h];
        const u32x4 qw = *(const u32x4*)(Qb + (size_t)(MSEQ + i) * AW + h * 64 + d8 * 8);
        u32x4 kw[16], vw[16];
#pragma unroll
        for (int m = 0; m < 16; ++m) { kw[m] = *(const u32x4*)(Kb + (size_t)(MSEQ + m) * KVW + kh * 64 + d8 * 8); vw[m] = *(const u32x4*)(Vb + (size_t)(MSEQ + m) * KVW + kh * 64 + d8 * 8); }
        float sc[16]; float mx = sink;
#pragma unroll
        for (int m = 0; m < 16; ++m) { float dot = 0.f;
#pragma unroll
            for (int e = 0; e < 4; ++e) dot += bflo(qw[e]) * bflo(kw[m][e]) + bfhi(qw[e]) * bfhi(kw[m][e]);
            dot += __shfl_xor(dot, 1); dot += __shfl_xor(dot, 2); dot += __shfl_xor(dot, 4);
            const int dist = i - m;
            sc[m] = (dist >= 0) ? dot * 0.125f + rel_bias[(dist < 0 ? 0 : dist) * 16 + h] : -1e30f;
            mx = fmaxf(mx, sc[m]); }
        float l = __builtin_amdgcn_exp2f((sink - mx) * LOG2E); float o[8];
#pragma unroll
        for (int e = 0; e < 8; ++e) o[e] = 0.f;
#pragma unroll
        for (int m = 0; m < 16; ++m) { const float p = __builtin_amdgcn_exp2f((sc[m] - mx) * LOG2E); l += p;
#pragma unroll
            for (int e = 0; e < 4; ++e) { o[2 * e] += p * bflo(vw[m][e]); o[2 * e + 1] += p * bfhi(vw[m][e]); } }
        const float inv = 1.0f / l;
        u32x4 w; w.x = cvt_pk_bf16(o[0] * inv, o[1] * inv); w.y = cvt_pk_bf16(o[2] * inv, o[3] * inv); w.z = cvt_pk_bf16(o[4] * inv, o[5] * inv); w.w = cvt_pk_bf16(o[6] * inv, o[7] * inv);
        *(u32x4*)(YA + (size_t)(MSEQ + i) * AW + h * 64 + d8 * 8) = w;
    }
}

__device__ __forceinline__ void sincos_acc(float x, float& sn, float& cs) {
    const float k = rintf(x * 0.636619772367581f);
    float r = fmaf(-k, 1.5703125f, x); r = fmaf(-k, 4.837512969970703125e-4f, r); r = fmaf(-k, 7.54978995489188216e-8f, r);
    const float r2 = r * r;
    const float sp = r + r * r2 * (-1.6666654611e-1f + r2 * (8.3321608736e-3f + r2 * (-1.9515295891e-4f)));
    const float cp = 1.0f - 0.5f * r2 + r2 * r2 * (4.166664568298827e-2f + r2 * (-1.388731625493765e-3f + r2 * 2.443315711809948e-5f));
    const int q = ((int)k) & 3;
    sn = (q == 0) ? sp : (q == 1) ? cp : (q == 2) ? -sp : -cp;
    cs = (q == 0) ? cp : (q == 1) ? -sp : (q == 2) ? -cp : sp;
}

__device__ __forceinline__ void ssm_tables(const Args& a, f32x2* AR, bf16_t* BB, int tid, int bid) {
    const int gt = bid * 512 + tid;
    if (gt < 2 * 64 * 64) {
        const int l = gt >> 12, g = (gt >> 6) & 63;
        const float lr = a.in[8][gt], li = a.in[9][gt], dt = expf(a.in[10][l * 64 + g]);
        const float decay = expf(lr * dt); float sn, cs; sincos_acc(li * dt, sn, cs);
        const float ar = decay * cs, ai = decay * sn;
        const float den = lr * lr + li * li, nr = ar - 1.0f, ni = ai;
        const float zr = (nr * lr + ni * li) / den, zi = (ni * lr - nr * li) / den;
        AR[gt] = (f32x2){ar, ai};
        const float* br = a.in[11] + (size_t)gt * 16; const float* bi = a.in[12] + (size_t)gt * 16;
        u32x4 wre[2], wim[2];
#pragma unroll
        for (int h = 0; h < 2; ++h) {
            float re[8], im[8];
#pragma unroll
            for (int e = 0; e < 8; ++e) { const float x = br[h * 8 + e], y = bi[h * 8 + e]; re[e] = zr * x - zi * y; im[e] = zr * y + zi * x; }
            wre[h] = (u32x4){cvt_pk_bf16(re[0], re[1]), cvt_pk_bf16(re[2], re[3]), cvt_pk_bf16(re[4], re[5]), cvt_pk_bf16(re[6], re[7])};
            wim[h] = (u32x4){cvt_pk_bf16(im[0], im[1]), cvt_pk_bf16(im[2], im[3]), cvt_pk_bf16(im[4], im[5]), cvt_pk_bf16(im[6], im[7])};
        }
        u32x4* o = (u32x4*)(BB + (size_t)gt * 32);
        o[0] = wre[0]; o[1] = wre[1]; o[2] = wim[0]; o[3] = wim[1];
    }
}

constexpr int SSM_XSTR = 132, SSM_WBYTES = 16 * SSM_XSTR * 4 + 16 * 272;
static_assert(8 * SSM_WBYTES <= LDS_BYTES, "ssm lds");
template <int PASS>
__device__ __forceinline__ void ssm_phase(const Args& a, int l, const bf16_t* U, bf16_t* Y, f32x2* SC, const f32x2* AR, const bf16_t* BB, LAS unsigned char* lds, int wave, int lane, int bid,
                                          const float* __restrict__ cvW = nullptr, bf16_t* __restrict__ cvWt = nullptr, int cvK = 64, int cvN = 64) {
    const float* c_re = a.in[13] + (size_t)l * 65536; const float* c_im = a.in[14] + (size_t)l * 65536; const float* dsk = a.in[15] + l * 1024;
    constexpr int NCH = (PASS == 1) ? 31 : 32;
    const int fr = lane & 15, quad = lane >> 4;
    LAS unsigned char* Xw = lds + wave * SSM_WBYTES;
    LAS unsigned char* Hw = Xw + 16 * SSM_XSTR * 4;
    int gprev = -1; float ar = 0.f, ai = 0.f, dskp = 0.f; bf16x8 bfA[8], cf[4];
#pragma unroll
    for (int i = 0; i < 8; ++i) bfA[i] = (bf16x8){0, 0, 0, 0, 0, 0, 0, 0};
#pragma unroll
    for (int i = 0; i < 4; ++i) cf[i] = (bf16x8){0, 0, 0, 0, 0, 0, 0, 0};
    int ct = bid * 8 + wave; const int cstride = gridDim.x * 8, ctn = cvN / 64, cntile = (PASS == 2 && cvW) ? ctn * (cvK / 64) : 0;
    for (int id = bid * 8 + wave; id < NB * 64 * NCH; id += gridDim.x * 8) {
        const int g = id & 63, c = (id >> 6) % NCH, b = id / (64 * NCH);
        float cf32[64]; const bool chave = (PASS == 2) && (ct < cntile); const int ck0 = (ct / ctn) * 64, cn0 = (ct % ctn) * 64;
        if (PASS == 2) {
            if (chave) { const float* csrc = cvW + (size_t)ck0 * cvN + cn0 + lane;
#pragma unroll
                for (int e = 0; e < 64; ++e) cf32[e] = csrc[(size_t)e * cvN]; }
            else {
#pragma unroll
                for (int e = 0; e < 64; ++e) cf32[e] = 0.f; }
        }
        if (g != gprev) {
            gprev = g;
            const f32x2 aa = AR[(l * 64 + g) * 64 + lane]; ar = aa.x; ai = aa.y;
#pragma unroll
            for (int mt = 0; mt < 8; ++mt) { u32x4 w = {0u, 0u, 0u, 0u}; if (quad < 2) w = *(const u32x4*)(BB + ((size_t)(l * 64 + g) * 128 + mt * 16 + fr) * 16 + quad * 8); bfA[mt] = __builtin_bit_cast(bf16x8, w); }
            if (PASS == 2) {
#pragma unroll
                for (int ks = 0; ks < 4; ++ks) { const f32x4 cr = *(const f32x4*)(c_re + (size_t)(g * 16 + fr) * 64 + ks * 16 + quad * 4), ci = *(const f32x4*)(c_im + (size_t)(g * 16 + fr) * 64 + ks * 16 + quad * 4);
                    u32x4 w; w.x = cvt_pk_bf16(cr[0], -ci[0]); w.y = cvt_pk_bf16(cr[1], -ci[1]); w.z = cvt_pk_bf16(cr[2], -ci[2]); w.w = cvt_pk_bf16(cr[3], -ci[3]);
                    cf[ks] = __builtin_bit_cast(bf16x8, w); }
                dskp = dsk[g * 16 + fr];
            }
        }
        float hr = 0.f, hi = 0.f;
        if (PASS == 2 && c > 0) {
            float pr = ar, pi = ai;
#pragma unroll
            for (int q = 0; q < 7; ++q) { const float t = pr * pr - pi * pi; pi = 2.0f * pr * pi; pr = t; }
            const f32x2* sc = SC + ((size_t)(b * 64 + g) * 32) * 64 + lane;
            const f32x2 s0 = sc[0]; hr = s0.x; hi = s0.y;
            f32x2 sv[31];
#pragma unroll
            for (int j = 0; j < 31; ++j) sv[j] = (j + 1 < c) ? sc[(j + 1) * 64] : (f32x2){0.f, 0.f};
#pragma unroll
            for (int j = 0; j < 31; ++j) if (j + 1 < c) { const float t = pr * hr - pi * hi + sv[j].x; hi = pr * hi + pi * hr + sv[j].y; hr = t; }
        }
        const int nblk = (c == 0) ? 9 : 8;
#define SSM_ROWBASE(k) ((c == 0) ? ((k) == 0 ? MSEQ : b * SEQ + ((k) - 1) * 16) : b * SEQ + c * 128 + (k) * 16)
#define SSM_LOADU(k) ((quad < 2) ? *(const u32x4*)(U + (size_t)(SSM_ROWBASE(k) + fr) * SW + g * 16 + quad * 8) : (u32x4){0u, 0u, 0u, 0u})
        u32x4 v1 = SSM_LOADU(0);
        {   const bf16x8 uf0 = __builtin_bit_cast(bf16x8, v1);
#pragma unroll
            for (int mt = 0; mt < 8; ++mt) { const f32x4 x = __builtin_amdgcn_mfma_f32_16x16x32_bf16(bfA[mt], uf0, (f32x4){0.f, 0.f, 0.f, 0.f}, 0, 0, 0);
                *(LAS f32x4*)(Xw + (fr * SSM_XSTR + mt * 16 + quad * 4) * 4) = x; } }
        if (nblk > 1) v1 = SSM_LOADU(1);
        for (int k = 0; k < nblk; ++k) {
            const int rb = SSM_ROWBASE(k);
            u32x4 v2 = v1;
            if (k + 2 < nblk) v2 = SSM_LOADU(k + 2);
            bf16_t usk[4] = {0, 0, 0, 0};
            if (PASS == 2) {
#pragma unroll
                for (int j = 0; j < 4; ++j) usk[j] = U[(size_t)(rb + quad * 4 + j) * SW + g * 16 + fr]; }
            asm volatile("s_waitcnt lgkmcnt(0)" ::: "memory");
            f32x2 xx[16];
#pragma unroll
            for (int tt = 0; tt < 16; ++tt) xx[tt] = *(const LAS f32x2*)(Xw + (tt * SSM_XSTR + 2 * lane) * 4);
            asm volatile("s_waitcnt lgkmcnt(0)" ::: "memory");
            if (k + 1 < nblk) { const bf16x8 uf1 = __builtin_bit_cast(bf16x8, v1);
#pragma unroll
                for (int mt = 0; mt < 8; ++mt) { const f32x4 x = __builtin_amdgcn_mfma_f32_16x16x32_bf16(bfA[mt], uf1, (f32x4){0.f, 0.f, 0.f, 0.f}, 0, 0, 0);
                    *(LAS f32x4*)(Xw + (fr * SSM_XSTR + mt * 16 + quad * 4) * 4) = x; } }
#pragma unroll
            for (int tt = 0; tt < 16; ++tt) {
                const float nhr = fmaf(ar, hr, fmaf(-ai, hi, xx[tt].x)), nhi = fmaf(ar, hi, fmaf(ai, hr, xx[tt].y));
                hr = nhr; hi = nhi;
                if (PASS == 2) *(LAS unsigned*)(Hw + tt * 272 + lane * 4) = cvt_pk_bf16(hr, hi);
            }
            if (PASS == 2) {
                const bool wr_ok = (rb < MSEQ) || (b == 0);
                asm volatile("s_waitcnt lgkmcnt(0)" ::: "memory");
                f32x4 acc = {0.f, 0.f, 0.f, 0.f};
#pragma unroll
                for (int ks = 0; ks < 4; ++ks) { const bf16x8 af = *(const LAS bf16x8*)(Hw + fr * 272 + ks * 64 + quad * 16); acc = __builtin_amdgcn_mfma_f32_16x16x32_bf16(af, cf[ks], acc, 0, 0, 0); }
#pragma unroll
                for (int j = 0; j < 4; ++j) { const size_t row = (size_t)(rb + quad * 4 + j);
                    const float uu = bf2f(usk[j]);
                    const float y = acc[j] + dskp * uu;
                    const float z2 = 1.5957691216f * (y + 0.044715f * y * y * y);
                    const float gy = y * __builtin_amdgcn_rcpf(1.0f + __builtin_amdgcn_exp2f(-z2 * LOG2E));
                    if (wr_ok) Y[row * SW + g * 16 + fr] = (bf16_t)(cvt_pk_bf16(gy, gy) & 0xffffu); }
            }
            asm volatile("s_waitcnt lgkmcnt(0)" ::: "memory");
            v1 = v2;
        }
#undef SSM_ROWBASE
#undef SSM_LOADU
        if (PASS == 1) SC[((size_t)(b * 64 + g) * 32 + c) * 64 + lane] = (f32x2){hr, hi};
        if (PASS == 2) {
            if (chave) { bf16_t* cdst = cvWt + (size_t)(cn0 + lane) * cvK + ck0;
#pragma unroll
                for (int kg = 0; kg < 8; ++kg) { u32x4 w; w.x = cvt_pk_bf16(cf32[kg * 8 + 0], cf32[kg * 8 + 1]); w.y = cvt_pk_bf16(cf32[kg * 8 + 2], cf32[kg * 8 + 3]); w.z = cvt_pk_bf16(cf32[kg * 8 + 4], cf32[kg * 8 + 5]); w.w = cvt_pk_bf16(cf32[kg * 8 + 6], cf32[kg * 8 + 7]);
                    *(u32x4*)(cdst + kg * 8) = w; } }
            ct += cstride;
        }
    }
    if (PASS == 2 && cvW) {
        for (; ct < cntile; ct += cstride) { const int k0 = (ct / ctn) * 64, n0 = (ct % ctn) * 64; const float* src = cvW + (size_t)k0 * cvN + n0 + lane; float f[64];
#pragma unroll
            for (int e = 0; e < 64; ++e) f[e] = src[(size_t)e * cvN];
            bf16_t* dst = cvWt + (size_t)(n0 + lane) * cvK + k0;
#pragma unroll
            for (int kg = 0; kg < 8; ++kg) { u32x4 w; w.x = cvt_pk_bf16(f[kg * 8 + 0], f[kg * 8 + 1]); w.y = cvt_pk_bf16(f[kg * 8 + 2], f[kg * 8 + 3]); w.z = cvt_pk_bf16(f[kg * 8 + 4], f[kg * 8 + 5]); w.w = cvt_pk_bf16(f[kg * 8 + 6], f[kg * 8 + 7]);
                *(u32x4*)(dst + kg * 8) = w; } }
    }
}

__device__ __forceinline__ void skinny_gemm(const pg8::Gemm& g, const pg8::EpiAll& E, LAS unsigned char* lds, int tid, int wave, int lane, int bid) {
    const int fr = lane & 15, quad = lane >> 4, K = g.K, kw = K >> 3;
    LAS f32x4* red = (LAS f32x4*)lds;
    for (int task = bid; task < (g.N >> 4); task += gridDim.x) {
        const int n0 = task << 4;
        const bf16_t* ap = g.A + (size_t)(MSEQ + fr) * K + wave * kw + quad * 8;
        const bf16_t* bp = g.Bt + (size_t)(n0 + fr) * K + wave * kw + quad * 8;
        f32x4 acc = {0.f, 0.f, 0.f, 0.f};
        for (int k = 0; k < kw; k += 256) {
            bf16x8 af[8], bf[8];
#pragma unroll
            for (int i = 0; i < 8; ++i) { af[i] = (bf16x8){0, 0, 0, 0, 0, 0, 0, 0}; bf[i] = af[i]; if (k + i * 32 < kw) { af[i] = *(const bf16x8*)(ap + k + i * 32); bf[i] = *(const bf16x8*)(bp + k + i * 32); } }
#pragma unroll
            for (int i = 0; i < 8; ++i) acc = __builtin_amdgcn_mfma_f32_16x16x32_bf16(af[i], bf[i], acc, 0, 0, 0);
        }
        red[wave * 64 + lane] = acc;
        __syncthreads();
        if (wave == 0) {
            f32x4 s = red[lane];
#pragma unroll
            for (int w = 1; w < 8; ++w) s = s + red[w * 64 + lane];
            const int col = n0 + fr;
            bf16_t xpre[4] = {0, 0, 0, 0}, opre[4] = {0, 0, 0, 0};
#pragma unroll
            for (int j = 0; j < 4; ++j) { const size_t row = (size_t)(MSEQ + quad * 4 + j);
                if (E.mode == 5) xpre[j] = E.X[row * D + col];
                else if (E.mode >= 1 && E.mode <= 3) { xpre[j] = E.X[row * E.ldx + col]; if (E.mode == 3) opre[j] = E.O[row * E.ldc + col]; } }
            asm volatile("" ::: "memory");
#pragma unroll
            for (int j = 0; j < 4; ++j) {
                const size_t row = (size_t)(MSEQ + quad * 4 + j); float v = s[j];
                if (E.mode == 5) { E.H[row * D + col] = bf2f(xpre[j]) * DN_ALPHA + v; }
                else {
                    bf16_t* op;
                    if (E.mode == 0) {
                        if (col < 1024) op = E.Q + row * AW + col;
                        else if (col < 1280) op = E.Kb + row * KVW + (col - 1024);
                        else if (col < 1536) op = E.Vb + row * KVW + (col - 1280);
                        else if (col < 2560) op = E.U + row * SW + (col - 1536);
                        else { op = E.G + row * 4096 + (col - 2560); v = sigmoid_f(v + E.gb[col - 2560]); }
                    } else {
                        op = E.O + row * E.ldc + col;
                        if (E.mode == 4) { v = fmaxf(v, 0.f); v = v * v; }
                        else { const float x = bf2f(xpre[j]);
                            if (E.mode == 1) v = x * sigmoid_f(v); else { v = v * x; if (E.mode == 3) v += bf2f(opre[j]); } }
                    }
                    *op = (bf16_t)(cvt_pk_bf16(v, v) & 0xffffu);
                }
            }
        }
        __syncthreads();
    }
}

__device__ __forceinline__ void fast_grid_barrier(unsigned* bar, unsigned gen, unsigned nblk) {
    asm volatile("s_waitcnt vmcnt(0) lgkmcnt(0)" ::: "memory");
    __syncthreads();
    if (threadIdx.x == 0) {
        __builtin_amdgcn_fence(__ATOMIC_RELEASE, "agent");
        asm volatile("s_waitcnt vmcnt(0)" ::: "memory");
        const unsigned old = __hip_atomic_fetch_add(bar, 1u, __ATOMIC_RELAXED, __HIP_MEMORY_SCOPE_AGENT);
        if (old == gen * nblk - 1u) {
            __builtin_amdgcn_fence(__ATOMIC_ACQUIRE, "agent");
            __hip_atomic_store(bar + 64, gen, __ATOMIC_RELEASE, __HIP_MEMORY_SCOPE_AGENT);
        } else {
            while (__hip_atomic_load(bar + 64, __ATOMIC_RELAXED, __HIP_MEMORY_SCOPE_AGENT) < gen) __builtin_amdgcn_s_sleep(1);
        }
        __builtin_amdgcn_fence(__ATOMIC_ACQUIRE, "agent");
        asm volatile("s_waitcnt vmcnt(0)" ::: "memory");
    }
    __syncthreads();
}

constexpr int NPHASE = 1 + 2 * 11;
__global__ void __launch_bounds__(512, 2) fwd_kernel(Args a) {
    extern __shared__ __attribute__((aligned(16))) unsigned char lds_raw[];
    LAS unsigned char* lds = (LAS unsigned char*)lds_raw;
    cg::grid_group grid = cg::this_grid();
    unsigned bgen = 0;
    for (int ph = a.ph_lo; ph < a.ph_hi; ++ph) {
#if PROBE_MASK
        const unsigned long long t_ph0 = __builtin_amdgcn_s_memrealtime();
#endif
        int tid = threadIdx.x, bid = blockIdx.x;
        asm volatile("" : "+v"(tid)); asm volatile("" : "+s"(bid));
        const int lane = tid & 63, wave = __builtin_amdgcn_readfirstlane(tid >> 6);
        unsigned char* ws = a.ws;
        float* H32 = (float*)(ws + OFF_H32);
        bf16_t* HB = (bf16_t*)(ws + OFF_HB);
        unsigned char* pool = ws + OFF_POOL;
        bf16_t* Qb = (bf16_t*)(pool + PO_Q); bf16_t* Kb = (bf16_t*)(pool + PO_K); bf16_t* Vb = (bf16_t*)(pool + PO_V); bf16_t* Ub = (bf16_t*)(pool + PO_U);
        bf16_t* Gb = (bf16_t*)(pool + PO_G); bf16_t* YA = (bf16_t*)(pool + PO_YA);
        bf16_t* YS = (bf16_t*)H32;
        bf16_t* MP = (bf16_t*)H32;
        float* RMIX = (float*)(pool + PO_G);
        bf16_t* YG = Ub;
        bf16_t* F1 = (bf16_t*)pool;
        unsigned char* wt = ws + OFF_WT;
        f32x2* SC = (f32x2*)(ws + OFF_SC); f32x2* AR = (f32x2*)(ws + OFF_AR); bf16_t* BB = (bf16_t*)(ws + OFF_BB);
        const int l = (ph - 1) / 11, kind = (ph == 0) ? -1 : (ph - 1) % 11;
        bool is_gemm = false; pg8::Gemm g{nullptr, nullptr, MPAD, 0, 0}; pg8::EpiAll E{};
        if (kind == 0 && EN(0)) { is_gemm = true; g = pg8::Gemm{HB, (const bf16_t*)(wt + WA_IN), MPAD, INW, D};
            E.mode = 0; E.Q = Qb; E.Kb = Kb; E.Vb = Vb; E.U = Ub; E.G = Gb; E.gb = a.in[6] + (size_t)l * 4096; }
        else if (kind == 3 && EN(3)) { is_gemm = true; g = pg8::Gemm{YS, (const bf16_t*)(wt + WA_GLU), MPAD, SW, SW}; E.mode = 1; E.O = YG; E.ldc = SW; E.X = YS; E.ldx = SW; }
        else if (kind == 4 && EN(4)) { is_gemm = true; g = pg8::Gemm{YA, (const bf16_t*)(wt + WA_AU), MPAD, D, AW}; E.mode = 2; E.O = MP; E.ldc = D; E.X = Gb; E.ldx = 4096; }
        else if (kind == 5 && EN(4)) { is_gemm = true; g = pg8::Gemm{YG, (const bf16_t*)(wt + WA_SU), MPAD, D, SW}; E.mode = 3; E.O = MP; E.ldc = D; E.X = Gb + 2048; E.ldx = 4096; }
        else if (kind == 6 && EN(5)) { is_gemm = true; g = pg8::Gemm{MP, (const bf16_t*)(wt + WA_OUT), MPAD, D, D}; E.mode = 5; E.H = RMIX; E.X = HB; }
        else if (kind == 8 && EN(7)) { is_gemm = true; g = pg8::Gemm{HB, (const bf16_t*)(wt + WB_UP), MPAD, DFF, D}; E.mode = 4; E.O = F1; E.ldc = DFF; }
        else if (kind == 9 && EN(8)) { is_gemm = true; g = pg8::Gemm{F1, (const bf16_t*)(wt + WB_DN), MPAD, D, DFF}; E.mode = 5; E.H = H32; E.X = HB; }
        if (is_gemm) {
            pg8::StaticOrder S; S.init(MSEQ, g.N, (int)gridDim.x, bid, kind == 9);
            pg8::gemm_phase(lds, g, S, E, tid);
            if (kind == 0) {
                const int nwg = (MSEQ / 256) * (INW / 256), rem = nwg % (int)gridDim.x;
                if (rem != 0 && bid >= rem) convert_mlp_down(a, l, wt, wave, lane, bid - rem, (int)gridDim.x - rem);
                else if (rem == 0) convert_mlp_down(a, l, wt, wave, lane, bid, (int)gridDim.x);
            }
            if (l == 0 || kind == 0) skinny_gemm(g, E, lds, tid, wave, lane, bid);
        } else if (ph == 0 && EN(10)) {
            ssm_tables(a, AR, BB, tid, bid);
            ln_phase<0>(a.in[0], a.in[1], a.in[2], a.in[3], H32, HB, nullptr, wave, lane, bid);
            convert_group_a(a, 0, wt, wave, lane, bid);
        } else if (kind == 1 && EN(1)) {
            attn_phase(Qb, Kb, Vb, YA, a.in[4], a.in[7] + l * 16, lds, tid, wave, lane, bid, l == 0);
            ssm_phase<1>(a, l, Ub, YS, SC, AR, BB, lds, wave, lane, bid);
        } else if (kind == 2 && EN(2)) {
            ssm_phase<2>(a, l, Ub, YS, SC, AR, BB, lds, wave, lane, bid, a.in[22] + (size_t)l * D * DFF, (bf16_t*)(wt + WB_UP), D, DFF);
        } else if (kind == 7 && EN(6)) {
            ln_phase<1>(nullptr, nullptr, a.in[20] + l * D, a.in[21] + l * D, RMIX, HB, nullptr, wave, lane, bid);
        } else if (kind == 10 && EN(9)) {
            if (l == 0) { ln_phase<1>(nullptr, nullptr, a.in[24], a.in[25], H32, HB, nullptr, wave, lane, bid); convert_group_a(a, 1, wt, wave, lane, bid); }
            else ln_phase<2>(nullptr, nullptr, a.in[24] + D, a.in[25] + D, H32, HB, a.out, wave, lane, bid);
        }
        if (ph + 1 < a.ph_hi && kind != 4) {
            if (ph == 0) grid.sync();
            else fast_grid_barrier((unsigned*)(a.ws + OFF_BAR), ++bgen, gridDim.x);
        }
#if PROBE_MASK
        if ((PROBE_MASK >> (kind + 1)) & 1) {
            const unsigned long long t1 = __builtin_amdgcn_s_memrealtime();
            while (__builtin_amdgcn_s_memrealtime() - t1 < (t1 - t_ph0)) __builtin_amdgcn_s_sleep(8);
        }
#endif
    }
}

extern "C" void kernel_launch(void* const* d_in, const int* in_sizes, int n_in, void* d_out, int out_size, void* d_ws, size_t ws_size, hipStream_t stream) {
    static int grid = 0;
    if (grid == 0) {
        if (n_in != 26 || ws_size < WS_END) { fprintf(stderr, "kernel_launch: need 26 inputs and %zu bytes of workspace (got %d, %zu)\n", (size_t)WS_END, n_in, ws_size); grid = -1; return; }
        int dev = 0, cus = 0, per_cu = 0;
        (void)hipGetDevice(&dev);
        (void)hipDeviceGetAttribute(&cus, hipDeviceAttributeMultiprocessorCount, dev);
        if (hipFuncSetAttribute((const void*)fwd_kernel, hipFuncAttributeMaxDynamicSharedMemorySize, LDS_BYTES) != hipSuccess) { fprintf(stderr, "kernel_launch: hipFuncSetAttribute failed\n"); grid = -1; return; }
        if (hipOccupancyMaxActiveBlocksPerMultiprocessor(&per_cu, (const void*)fwd_kernel, 512, LDS_BYTES) != hipSuccess || per_cu < 1) { fprintf(stderr, "kernel_launch: occupancy query says %d\n", per_cu); per_cu = 1; }
        (void)hipGetLastError();
        grid = cus;
    }
    if (grid < 0) return;
    Args a{};
    for (int i = 0; i < 26; ++i) a.in[i] = (const float*)d_in[i];
    a.out = (float*)d_out; a.ws = (unsigned char*)d_ws; a.ph_lo = 0; a.ph_hi = NPHASE;
    (void)hipMemsetAsync((unsigned char*)d_ws + OFF_BAR, 0, SZ_BAR, stream);
    void* args[] = {&a};
    hipError_t e = hipLaunchCooperativeKernel((const void*)fwd_kernel, dim3(grid), dim3(512), args, LDS_BYTES, stream);
    if (e != hipSuccess) fprintf(stderr, "kernel_launch: cooperative launch failed: %s (grid %d)\n", hipGetErrorString(e), grid);
}
```

```cpp
#include <hip/hip_runtime.h>
#include <hip/hip_cooperative_groups.h>
#include <cstdio>
namespace cg = cooperative_groups;

#define LAS __attribute__((address_space(3)))
typedef unsigned short bf16_t;
typedef short bf16x8 __attribute__((ext_vector_type(8)));
typedef float f32x4 __attribute__((ext_vector_type(4)));
typedef float f32x2 __attribute__((ext_vector_type(2)));
typedef unsigned u32x4 __attribute__((ext_vector_type(4)));
typedef unsigned u32x2 __attribute__((ext_vector_type(2)));

constexpr int D = 2048, NB = 4, SEQ = 4096, NMETA = 16;
constexpr int MSEQ = NB * SEQ;
constexpr int MROWS = MSEQ + NMETA;
constexpr int MPAD = MROWS;
constexpr int INW = 6656, DFF = 8192, AW = 1024, KVW = 256, SW = 1024;
constexpr float DN_ALPHA = 1.41421356237f;
constexpr float LOG2E = 1.44269504089f;

constexpr size_t OFF_H32 = 0;
constexpr size_t SZ_H32 = (size_t)MPAD * D * 4;
constexpr size_t OFF_HB = OFF_H32 + SZ_H32;
constexpr size_t SZ_HB = (size_t)MPAD * D * 2;
constexpr size_t OFF_POOL = OFF_HB + SZ_HB;
constexpr size_t SZ_POOL = (size_t)MPAD * DFF * 2;
constexpr size_t PO_Q = 0;
constexpr size_t PO_K = PO_Q + (size_t)MPAD * AW * 2;
constexpr size_t PO_V = PO_K + (size_t)MPAD * KVW * 2;
constexpr size_t PO_U = PO_V + (size_t)MPAD * KVW * 2;
constexpr size_t PO_G = PO_U + (size_t)MPAD * SW * 2;
constexpr size_t PO_YA = PO_G + (size_t)MPAD * 4096 * 2;
static_assert(PO_YA + (size_t)MPAD * AW * 2 <= SZ_POOL, "pool");
constexpr size_t OFF_WT = OFF_POOL + SZ_POOL;
constexpr size_t SZ_WT = ((size_t)INW * D + (size_t)SW * SW + 2 * (size_t)SW * D + (size_t)D * D) * 2 + (size_t)2 * D * DFF * 2;
constexpr size_t WA_IN = 0;
constexpr size_t WA_GLU = WA_IN + (size_t)INW * D * 2;
constexpr size_t WA_AU = WA_GLU + (size_t)SW * SW * 2;
constexpr size_t WA_SU = WA_AU + (size_t)AW * D * 2;
constexpr size_t WA_OUT = WA_SU + (size_t)SW * D * 2;
constexpr size_t WB_UP = WA_OUT + (size_t)D * D * 2;
constexpr size_t WB_DN = WB_UP + (size_t)D * DFF * 2;
static_assert(WB_DN + (size_t)D * DFF * 2 == SZ_WT, "wt");
constexpr size_t OFF_SC = OFF_WT + SZ_WT;
constexpr size_t SZ_SC = (size_t)NB * 64 * 32 * 64 * 8;
constexpr size_t OFF_AR = OFF_SC + SZ_SC;
constexpr size_t SZ_AR = (size_t)2 * 64 * 64 * 8;
constexpr size_t OFF_BB = OFF_AR + SZ_AR;
constexpr size_t SZ_BB = (size_t)2 * 64 * 128 * 16 * 2;
constexpr size_t OFF_BAR = OFF_BB + SZ_BB;
constexpr size_t SZ_BAR = 1024;
constexpr size_t WS_END = OFF_BAR + SZ_BAR;

constexpr int LDS_BYTES = 140864;
#ifndef ONLY
#define ONLY -1
#endif
#ifndef MASK
#define MASK 0xFFFF
#endif
#ifndef PROBE_MASK
#define PROBE_MASK 0
#endif
#define EN(k) (((MASK) >> (k)) & 1)

struct Args { const float* in[26]; float* out; unsigned char* ws; int ph_lo, ph_hi; };

__device__ __forceinline__ unsigned cvt_pk_bf16(float lo, float hi) { unsigned r; asm volatile("v_cvt_pk_bf16_f32 %0, %1, %2" : "=v"(r) : "v"(lo), "v"(hi)); return r; }
__device__ __forceinline__ float bflo(unsigned w) { return __uint_as_float(w << 16); }
__device__ __forceinline__ float bfhi(unsigned w) { return __uint_as_float(w & 0xffff0000u); }
__device__ __forceinline__ float bf2f(bf16_t v) { return __uint_as_float(((unsigned)v) << 16); }
__device__ __forceinline__ float sigmoid_f(float x) { return __builtin_amdgcn_rcpf(1.0f + __builtin_amdgcn_exp2f(-x * LOG2E)); }
template <int CTRL> __device__ __forceinline__ float dpp_f(float v) { return __int_as_float(__builtin_amdgcn_update_dpp(0, __float_as_int(v), CTRL, 0xf, 0xf, true)); }
__device__ __forceinline__ float row16_max(float v) { v = fmaxf(v, dpp_f<0xB1>(v)); v = fmaxf(v, dpp_f<0x4E>(v)); v = fmaxf(v, dpp_f<0x141>(v)); v = fmaxf(v, dpp_f<0x140>(v)); return v; }
__device__ __forceinline__ float row16_sum(float v) { v += dpp_f<0xB1>(v); v += dpp_f<0x4E>(v); v += dpp_f<0x141>(v); v += dpp_f<0x140>(v); return v; }
__device__ __forceinline__ float wave_sum(float v) { for (int o = 32; o > 0; o >>= 1) v += __shfl_xor(v, o); return v; }
__device__ __forceinline__ int t5_bucket(int n) {
    if (n < 16) return n;
    return 16 + (n >= 19) + (n >= 21) + (n >= 24) + (n >= 27) + (n >= 31) + (n >= 35) + (n >= 40) + (n >= 46) + (n >= 52) + (n >= 59) + (n >= 67) + (n >= 77) + (n >= 87) + (n >= 99) + (n >= 113);
}

namespace pg8 {
constexpr int BM = 256, BK = 64, HALF = 128, HTB = HALF * BK * 2, STAGE_BYTES = 8 * HTB, NXCD = 8, WGM = 4;
__device__ __forceinline__ int lds_byte(int r, int c) { const int st = (r >> 4) * 2 + (c >> 5), rr = r & 15, cc = c & 31, ob = rr * 64 + cc * 2; return st * 1024 + (ob ^ (((ob >> 9) & 1) << 5)); }
__device__ __forceinline__ void stage_rc(int b, int& R, int& C) { const int st = b / 1024, sb = b % 1024, swz = sb ^ (((sb >> 9) & 1) << 5); R = (st >> 1) * 16 + swz / 64; C = (st & 1) * 32 + (swz % 64) / 2; }
__device__ __forceinline__ int perm32(int rho) { const int n = rho >> 4, i = rho & 15; return 8 * (i >> 2) + 4 * n + (i & 3); }
struct Unit { int pm, pn; };
struct Gemm { const bf16_t* A; const bf16_t* Bt; int M, N, K; };
struct StaticOrder {
    int nM, nN, nwg, G, c, rev;
    __device__ void init(int M, int N, int G_, int c_, int rev_ = 0) { nM = M / BM; nN = N / BM; nwg = nM * nN; G = G_; c = c_; rev = (rev_ && nwg % G_ == 0) ? nwg / G_ : 0; }
    __device__ bool next(int i, Unit& u) const {
        if (rev && i >= rev) return false;
        const long L = (long)(rev ? rev - 1 - i : i) * G + c; if (L >= nwg) return false;
        int wgid = (int)L; { const int q = nwg / NXCD, r = nwg % NXCD, xcd = wgid % NXCD, off = wgid / NXCD; wgid = (xcd < r ? xcd * (q + 1) : r * (q + 1) + (xcd - r) * q) + off; }
        const int nig = WGM * nN, gid = wgid / nig, fm = gid * WGM, gsz = (nM - fm) < WGM ? (nM - fm) : WGM;
        u.pm = fm + ((wgid % nig) % gsz); u.pn = (wgid % nig) / gsz; return true;
    }
};
template <class Epi>
__device__ __forceinline__ void gemm_phase(LAS unsigned char* lds, const Gemm g, const StaticOrder& S, const Epi& E, const int tid) {
    const int wid = __builtin_amdgcn_readfirstlane(tid >> 6), lane = tid & 63, wr = wid >> 2, wc = wid & 3, fr = lane & 15, fq = lane >> 4;
    const int K = g.K, nt = K / BK;
    unsigned voffA[2], voffB[2];
#pragma unroll
    for (int i = 0; i < 2; ++i) { int R, C; stage_rc(tid * 16 + i * 8192, R, C); const int Rb = E.perm() ? ((R & ~31) + perm32(R & 31)) : R;
        voffA[i] = (unsigned)(R * K + C) * 2u; voffB[i] = (unsigned)(Rb * K + C) * 2u; }
    const size_t kstep = (size_t)(BK * 2);
    const size_t hstep = (size_t)HALF * K * 2;
    const size_t tstep = 2 * hstep;
    const unsigned ldsw = (unsigned)wid * 1024u;
    const int aoff = lds_byte(wr * 64 + fr, fq * 8), boff = lds_byte(wc * 32 + fr, fq * 8);
#define PG8_SA(b, h) (((b) * 2 + (h)) * HTB)
#define PG8_SB(b, h) ((4 + (b) * 2 + (h)) * HTB)
#define PG8_STAGE(bufoff, gbase, voff) do { _Pragma("unroll") for (int _i = 0; _i < 2; ++_i) \
        __builtin_amdgcn_global_load_lds((const unsigned*)((const char*)(gbase) + (voff)[_i]), (LAS unsigned*)(lds + (bufoff) + ldsw + _i * 8192), 16, 0, 0); } while (0)
#define PG8_LDA(dst, b, h) do { _Pragma("unroll") for (int m = 0; m < 4; ++m) _Pragma("unroll") for (int k = 0; k < 2; ++k) dst[m][k] = *(const LAS bf16x8*)(lds + PG8_SA(b, h) + aoff + m * 2048 + k * 1024); } while (0)
#define PG8_LDB(dst, b, h) do { _Pragma("unroll") for (int n = 0; n < 2; ++n) _Pragma("unroll") for (int k = 0; k < 2; ++k) dst[n][k] = *(const LAS bf16x8*)(lds + PG8_SB(b, h) + boff + n * 2048 + k * 1024); } while (0)
#define PG8_MMA(ai, bj, At, Bt) do { __builtin_amdgcn_s_setprio(1); _Pragma("unroll") for (int m = 0; m < 4; ++m) _Pragma("unroll") for (int n = 0; n < 2; ++n) _Pragma("unroll") for (int k = 0; k < 2; ++k) \
        acc[ai][bj][m][n] = __builtin_amdgcn_mfma_f32_16x16x32_bf16(Bt[n][k], At[m][k], acc[ai][bj][m][n], 0, 0, 0); __builtin_amdgcn_s_setprio(0); } while (0)
#define PG8_WAIT_V(n) asm volatile("s_waitcnt vmcnt(" #n ")" ::: "memory")
#define PG8_WAIT_L(n) asm volatile("s_waitcnt lgkmcnt(" #n ")" ::: "memory")
#define PG8_BAR __builtin_amdgcn_s_barrier()
#define PG8_SCHED __builtin_amdgcn_sched_barrier(0)
    Unit cur, nxt; int ui = 0;
    if (!S.next(0, cur)) return;
    f32x4 acc[2][2][4][2];
#pragma unroll
    for (int a = 0; a < 2; ++a)
#pragma unroll
        for (int b = 0; b < 2; ++b)
#pragma unroll
            for (int m = 0; m < 4; ++m)
#pragma unroll
                for (int n = 0; n < 2; ++n) acc[a][b][m][n] = (f32x4){0.f, 0.f, 0.f, 0.f};
    bf16x8 At[4][2], B0[2][2], B1[2][2];
    const char* cA = (const char*)g.A + (size_t)cur.pm * tstep; const char* cB = (const char*)g.Bt + (size_t)cur.pn * tstep;
    PG8_STAGE(PG8_SB(0, 0), cB, voffB); PG8_STAGE(PG8_SA(0, 0), cA, voffA); PG8_STAGE(PG8_SB(0, 1), cB + hstep, voffB); PG8_STAGE(PG8_SA(0, 1), cA + hstep, voffA);
    if (wr == 1) PG8_BAR;
    PG8_WAIT_V(4); PG8_BAR;
    PG8_STAGE(PG8_SB(1, 0), cB + kstep, voffB); PG8_STAGE(PG8_SA(1, 0), cA + kstep, voffA); PG8_STAGE(PG8_SB(1, 1), cB + hstep + kstep, voffB);
    PG8_WAIT_V(6); PG8_BAR;
    for (;;) {
        const bool has_next = S.next(ui + 1, nxt);
        const char* nA = has_next ? (const char*)g.A + (size_t)nxt.pm * tstep : cA; const char* nB = has_next ? (const char*)g.Bt + (size_t)nxt.pn * tstep : cB;
        for (int t = 0; t < nt; t += 2) {
            const bool last = (t == nt - 2);
            const char* a1 = cA + (size_t)(t + 1) * kstep;
            const char* a2 = last ? nA : cA + (size_t)(t + 2) * kstep; const char* b2 = last ? nB : cB + (size_t)(t + 2) * kstep;
            const char* a3 = a2 + kstep; const char* b3 = b2 + kstep;
            PG8_LDB(B0, 0, 0); PG8_SCHED; PG8_LDA(At, 0, 0); PG8_STAGE(PG8_SA(1, 1), a1 + hstep, voffA);
            PG8_WAIT_L(8); PG8_BAR; PG8_WAIT_L(0); PG8_MMA(0, 0, At, B0); PG8_BAR; PG8_SCHED;
            PG8_LDB(B1, 0, 1); PG8_STAGE(PG8_SB(0, 0), b2, voffB);
            PG8_BAR; PG8_WAIT_L(0); PG8_MMA(0, 1, At, B1); PG8_BAR;
            PG8_LDA(At, 0, 1); PG8_STAGE(PG8_SA(0, 0), a2, voffA);
            PG8_BAR; PG8_WAIT_L(0); PG8_MMA(1, 0, At, B0); PG8_BAR; PG8_SCHED;
            PG8_STAGE(PG8_SB(0, 1), b2 + hstep, voffB);
            PG8_WAIT_V(6); PG8_BAR; PG8_MMA(1, 1, At, B1); PG8_BAR;
            PG8_LDB(B0, 1, 0); PG8_SCHED; PG8_LDA(At, 1, 0); PG8_STAGE(PG8_SA(0, 1), a2 + hstep, voffA);
            PG8_WAIT_L(8); PG8_BAR; PG8_WAIT_L(0); PG8_MMA(0, 0, At, B0); PG8_BAR; PG8_SCHED;
            PG8_LDB(B1, 1, 1); PG8_STAGE(PG8_SB(1, 0), b3, voffB);
            PG8_BAR; PG8_WAIT_L(0); PG8_MMA(0, 1, At, B1); PG8_BAR;
            PG8_LDA(At, 1, 1); PG8_STAGE(PG8_SA(1, 0), a3, voffA);
            PG8_BAR; PG8_WAIT_L(0); PG8_MMA(1, 0, At, B0); PG8_BAR; PG8_SCHED;
            PG8_STAGE(PG8_SB(1, 1), b3 + hstep, voffB);
            PG8_WAIT_V(6); PG8_BAR; PG8_MMA(1, 1, At, B1); PG8_BAR;
        }
        E(acc, cur, wr, wc, fr, fq);
        if (!has_next) break;
#pragma unroll
        for (int a = 0; a < 2; ++a)
#pragma unroll
            for (int b = 0; b < 2; ++b)
#pragma unroll
                for (int m = 0; m < 4; ++m)
#pragma unroll
                    for (int n = 0; n < 2; ++n) acc[a][b][m][n] = (f32x4){0.f, 0.f, 0.f, 0.f};
        cur = nxt; cA = nA; cB = nB; ++ui;
    }
    PG8_WAIT_V(0);
    if (wr == 0) PG8_BAR;
    PG8_BAR;
#undef PG8_SA
#undef PG8_SB
#undef PG8_STAGE
#undef PG8_LDA
#undef PG8_LDB
#undef PG8_MMA
#undef PG8_WAIT_V
#undef PG8_WAIT_L
#undef PG8_BAR
#undef PG8_SCHED
}

typedef f32x4 Acc[2][2][4][2];
struct EpiAll {
    int mode;
    bf16_t* O; int ldc; const bf16_t* X; int ldx; float* H;
    bf16_t *Q, *Kb, *Vb, *U, *G; const float* gb;
    __device__ __forceinline__ bool perm() const { return mode != 5; }
    __device__ __forceinline__ void operator()(const Acc& acc, const Unit& u, int wr, int wc, int fr, int fq) const {
        if (mode == 5) {
            const int row0 = u.pm * BM + wr * 64 + fr, col0 = u.pn * BM + wc * 32 + 4 * fq;
            u32x2 hw[2][4][2][2];
#pragma unroll
            for (int ai = 0; ai < 2; ++ai)
#pragma unroll
                for (int m = 0; m < 4; ++m) { const bf16_t* hbp = X + (size_t)(row0 + ai * HALF + m * 16) * D + col0;
#pragma unroll
                    for (int bj = 0; bj < 2; ++bj)
#pragma unroll
                        for (int n = 0; n < 2; ++n) hw[ai][m][bj][n] = *(const u32x2*)(hbp + bj * HALF + n * 16); }
            asm volatile("" ::: "memory");
#pragma unroll
            for (int ai = 0; ai < 2; ++ai)
#pragma unroll
                for (int m = 0; m < 4; ++m) { float* rowp = H + (size_t)(row0 + ai * HALF + m * 16) * D + col0;
#pragma unroll
                    for (int bj = 0; bj < 2; ++bj)
#pragma unroll
                        for (int n = 0; n < 2; ++n) { const u32x2 w = hw[ai][m][bj][n]; const f32x4 h = {bflo(w.x), bfhi(w.x), bflo(w.y), bfhi(w.y)}; const f32x4 rr = h * DN_ALPHA + acc[ai][bj][m][n];
                            if (H) *(f32x4*)(rowp + bj * HALF + n * 16) = rr;
                            else { u32x2 pw; pw.x = cvt_pk_bf16(rr[0], rr[1]); pw.y = cvt_pk_bf16(rr[2], rr[3]); *(u32x2*)(O + (size_t)(row0 + ai * HALF + m * 16) * D + col0 + bj * HALF + n * 16) = pw; } } }
            return;
        }
        bf16_t* base = O; int ld = ldc, colt = u.pn * BM; bool gate = false;
        if (mode == 0) { const int pn = u.pn;
            if (pn < 4) { base = Q; ld = AW; colt = pn * 256; }
            else if (pn == 4) { base = Kb; ld = KVW; colt = 0; }
            else if (pn == 5) { base = Vb; ld = KVW; colt = 0; }
            else if (pn < 10) { base = U; ld = SW; colt = (pn - 6) * 256; }
            else { base = G; ld = 4096; colt = (pn - 10) * 256; gate = true; } }
        const int row0 = u.pm * BM + wr * 64 + fr, col0 = colt + wc * 32 + 8 * fq;
        f32x4 bv[2][2];
#pragma unroll
        for (int bj = 0; bj < 2; ++bj)
#pragma unroll
            for (int n = 0; n < 2; ++n) bv[bj][n] = gate ? *(const f32x4*)(gb + col0 + bj * HALF + 4 * n) : (f32x4){0.f, 0.f, 0.f, 0.f};
        const bool need_x = (mode >= 1 && mode <= 3), need_o = (mode == 3);
#pragma unroll
        for (int ai = 0; ai < 2; ++ai)
#pragma unroll
        for (int mh = 0; mh < 2; ++mh) {
            u32x4 xw[2][2], ow[2][2];
#pragma unroll
            for (int mm = 0; mm < 2; ++mm)
#pragma unroll
                for (int bj = 0; bj < 2; ++bj) { const size_t r = (size_t)(row0 + ai * HALF + (mh * 2 + mm) * 16);
                    xw[mm][bj] = (u32x4){0u, 0u, 0u, 0u}; ow[mm][bj] = (u32x4){0u, 0u, 0u, 0u};
                    if (need_x) xw[mm][bj] = *(const u32x4*)(X + r * ldx + col0 + bj * HALF);
                    if (need_o) ow[mm][bj] = *(const u32x4*)(base + r * ld + col0 + bj * HALF); }
            asm volatile("" ::: "memory");
#pragma unroll
            for (int mm = 0; mm < 2; ++mm) { const int m = mh * 2 + mm; const size_t r = (size_t)(row0 + ai * HALF + m * 16);
#pragma unroll
                for (int bj = 0; bj < 2; ++bj) { f32x4 v0 = acc[ai][bj][m][0] + bv[bj][0], v1 = acc[ai][bj][m][1] + bv[bj][1];
                    bf16_t* op = base + r * ld + col0 + bj * HALF;
                    if (mode == 0) {
                        if (gate) {
#pragma unroll
                            for (int j = 0; j < 4; ++j) { v0[j] = sigmoid_f(v0[j]); v1[j] = sigmoid_f(v1[j]); } }
                    } else if (mode == 4) {
#pragma unroll
                        for (int j = 0; j < 4; ++j) { const float a0 = fmaxf(v0[j], 0.f), a1 = fmaxf(v1[j], 0.f); v0[j] = a0 * a0; v1[j] = a1 * a1; }
                    } else {
                        const u32x4 xv = xw[mm][bj];
                        const f32x4 x0 = {bflo(xv.x), bfhi(xv.x), bflo(xv.y), bfhi(xv.y)}, x1 = {bflo(xv.z), bfhi(xv.z), bflo(xv.w), bfhi(xv.w)};
                        if (mode == 1) {
#pragma unroll
                            for (int j = 0; j < 4; ++j) { v0[j] = x0[j] * sigmoid_f(v0[j]); v1[j] = x1[j] * sigmoid_f(v1[j]); }
                        } else { v0 = v0 * x0; v1 = v1 * x1;
                            if (mode == 3) { const u32x4 ov = ow[mm][bj];
                                const f32x4 o0 = {bflo(ov.x), bfhi(ov.x), bflo(ov.y), bfhi(ov.y)}, o1 = {bflo(ov.z), bfhi(ov.z), bflo(ov.w), bfhi(ov.w)};
                                v0 = v0 + o0; v1 = v1 + o1; } }
                    }
                    u32x4 w; w.x = cvt_pk_bf16(v0[0], v0[1]); w.y = cvt_pk_bf16(v0[2], v0[3]); w.z = cvt_pk_bf16(v1[0], v1[1]); w.w = cvt_pk_bf16(v1[2], v1[3]);
                    *(u32x4*)op = w; } }
            asm volatile("" ::: "memory");
        }
    }
};
}

template <int MODE>
__device__ __forceinline__ void ln_phase(const float* x, const float* meta, const float* gam, const float* bet, float* H32, bf16_t* HB, float* out, int wave, int lane, int bid) {
    const int gw = bid * 8 + wave, nw = gridDim.x * 8;
    const int nrows = (MODE == 2) ? MSEQ : MPAD;
    f32x4 gv[8], bv[8];
#pragma unroll
    for (int i = 0; i < 8; ++i) { gv[i] = *(const f32x4*)(gam + i * 256 + lane * 4); bv[i] = *(const f32x4*)(bet + i * 256 + lane * 4); }
    for (int r = gw; r < nrows; r += nw) {
        const float* src;
        if (MODE == 0) src = (r < MSEQ) ? x + (size_t)r * D : meta + (size_t)(r - MSEQ) * D;
        else src = H32 + (size_t)r * D;
        f32x4 v[8];
        if (src) {
            if (MODE == 1) {
                const bf16_t* s16 = (const bf16_t*)H32 + (size_t)r * D;
#pragma unroll
                for (int i = 0; i < 8; ++i) { const u32x2 w = *(const u32x2*)(s16 + i * 256 + lane * 4); v[i] = (f32x4){bflo(w.x), bfhi(w.x), bflo(w.y), bfhi(w.y)}; }
            } else {
#pragma unroll
                for (int i = 0; i < 8; ++i) v[i] = *(const f32x4*)(src + i * 256 + lane * 4);
            }
            float s = 0.f;
#pragma unroll
            for (int i = 0; i < 8; ++i) s += (v[i][0] + v[i][1]) + (v[i][2] + v[i][3]);
            const float mu = wave_sum(s) * (1.0f / D);
            float q = 0.f;
#pragma unroll
            for (int i = 0; i < 8; ++i) { v[i] = v[i] - mu; q += (v[i][0] * v[i][0] + v[i][1] * v[i][1]) + (v[i][2] * v[i][2] + v[i][3] * v[i][3]); }
            const float rstd = 1.0f / sqrtf(wave_sum(q) * (1.0f / D) + 1e-5f);
#pragma unroll
            for (int i = 0; i < 8; ++i) v[i] = v[i] * rstd * gv[i] + bv[i];
        } else {
#pragma unroll
            for (int i = 0; i < 8; ++i) v[i] = (f32x4){0.f, 0.f, 0.f, 0.f};
        }
        if (MODE == 2) {
#pragma unroll
            for (int i = 0; i < 8; ++i) *(f32x4*)(out + (size_t)r * D + i * 256 + lane * 4) = v[i];
        } else {
#pragma unroll
            for (int i = 0; i < 8; ++i) {
                u32x2 w; w.x = cvt_pk_bf16(v[i][0], v[i][1]); w.y = cvt_pk_bf16(v[i][2], v[i][3]); *(u32x2*)(HB + (size_t)r * D + i * 256 + lane * 4) = w; }
        }
    }
}

__device__ __forceinline__ void convert_wt(const float* __restrict__ W, bf16_t* __restrict__ Wt, int K, int N, int wave, int lane, int bid, int nblk) {
    const int tn = N / 64, ntile = tn * (K / 64);
    for (int t = bid * 8 + wave; t < ntile; t += nblk * 8) {
        const int k0 = (t / tn) * 64, n0 = (t % tn) * 64;
        const float* src = W + (size_t)k0 * N + n0 + lane;
        float f[64];
#pragma unroll
        for (int e = 0; e < 64; ++e) f[e] = src[(size_t)e * N];
        bf16_t* dst = Wt + (size_t)(n0 + lane) * K + k0;
#pragma unroll
        for (int kg = 0; kg < 8; ++kg) { u32x4 w; w.x = cvt_pk_bf16(f[kg * 8 + 0], f[kg * 8 + 1]); w.y = cvt_pk_bf16(f[kg * 8 + 2], f[kg * 8 + 3]); w.z = cvt_pk_bf16(f[kg * 8 + 4], f[kg * 8 + 5]); w.w = cvt_pk_bf16(f[kg * 8 + 6], f[kg * 8 + 7]);
            *(u32x4*)(dst + kg * 8) = w; }
    }
}
__device__ __forceinline__ void convert_group_a(const Args& a, int l, unsigned char* wt, int wave, int lane, int bid) {
    convert_wt(a.in[5] + (size_t)l * D * INW, (bf16_t*)(wt + WA_IN), D, INW, wave, lane, bid, (int)gridDim.x);
    convert_wt(a.in[16] + (size_t)l * SW * SW, (bf16_t*)(wt + WA_GLU), SW, SW, wave, lane, bid, (int)gridDim.x);
    convert_wt(a.in[17] + (size_t)l * AW * D, (bf16_t*)(wt + WA_AU), AW, D, wave, lane, bid, (int)gridDim.x);
    convert_wt(a.in[18] + (size_t)l * SW * D, (bf16_t*)(wt + WA_SU), SW, D, wave, lane, bid, (int)gridDim.x);
    convert_wt(a.in[19] + (size_t)l * D * D, (bf16_t*)(wt + WA_OUT), D, D, wave, lane, bid, (int)gridDim.x);
}
__device__ __forceinline__ void convert_mlp_up(const Args& a, int l, unsigned char* wt, int wave, int lane, int bid, int nblk) {
    convert_wt(a.in[22] + (size_t)l * D * DFF, (bf16_t*)(wt + WB_UP), D, DFF, wave, lane, bid, nblk);
}
__device__ __forceinline__ void convert_mlp_down(const Args& a, int l, unsigned char* wt, int wave, int lane, int bid, int nblk) {
    convert_wt(a.in[23] + (size_t)l * DFF * D, (bf16_t*)(wt + WB_DN), DFF, D, wave, lane, bid, nblk);
}

constexpr int AT_KSTR = 72, AT_VSTR = 296, AT_PSTR = 232;
constexpr int AT_K_OFF = 0, AT_V_OFF = 288 * AT_KSTR * 2, AT_P_OFF = AT_V_OFF + 64 * AT_VSTR * 2, AT_T_OFF = AT_P_OFF + 8 * 16 * AT_PSTR * 2, AT_END = AT_T_OFF + 4 * 132 * 4;
static_assert(AT_END <= LDS_BYTES, "attn lds");

__device__ __forceinline__ void attn_phase(const bf16_t* Qb, const bf16_t* Kb, const bf16_t* Vb, bf16_t* YA, const float* rel_bias, const float* sinks,
                                           LAS unsigned char* lds, int tid, int wave, int lane, int bid, bool meta_q) {
    LAS bf16_t* vt = (LAS bf16_t*)(lds + AT_V_OFF);
    LAS float* tab = (LAS float*)(lds + AT_T_OFF);
    const int fr = lane & 15, quad = lane >> 4;
    for (int it = bid; it < NB * 32 * 4; it += gridDim.x) {
        const int b = it >> 7, nb = (it >> 2) & 31, kh = it & 3;
        {
            u32x4 kvr[5], vvr[5];
#pragma unroll
            for (int i = 0; i < 5; ++i) { const int c = tid + i * 512; kvr[i] = (u32x4){0u, 0u, 0u, 0u}; vvr[i] = (u32x4){0u, 0u, 0u, 0u};
                if (c < 272 * 8) { const int kk = c >> 3, part = c & 7; int row; bool ok = true;
                    if (kk < 16) row = MSEQ + kk;
                    else if (kk < 144) { row = b * SEQ + nb * 128 - 128 + (kk - 16); ok = nb > 0; }
                    else row = b * SEQ + nb * 128 + (kk - 144);
                    if (ok) { kvr[i] = *(const u32x4*)(Kb + (size_t)row * KVW + kh * 64 + part * 8); vvr[i] = *(const u32x4*)(Vb + (size_t)row * KVW + kh * 64 + part * 8); } } }
#pragma unroll
            for (int i = 0; i < 5; ++i) { const int c = tid + i * 512;
                if (c < 272 * 8) { const int kk = c >> 3, part = c & 7, lr = kk < 16 ? kk : kk + 16;
                    *(LAS u32x4*)(lds + AT_K_OFF + (lr * AT_KSTR + part * 8) * 2) = kvr[i];
#pragma unroll
                    for (int e2 = 0; e2 < 8; ++e2) vt[(part * 8 + e2) * AT_VSTR + lr] = (bf16_t)(vvr[i][e2 >> 1] >> ((e2 & 1) * 16)); } }
        }
        for (int c = tid; c < 1024; c += 512) vt[(c >> 4) * AT_VSTR + 16 + (c & 15)] = 0;
        for (int c = tid; c < 4 * 129; c += 512) { const int g = c / 129, dd = c - g * 129; tab[g * 132 + dd] = rel_bias[t5_bucket(dd) * 16 + kh * 4 + g]; }
        __syncthreads();
        {
            const int g = wave >> 1, half = wave & 1, h = kh * 4 + g;
            const float sink = sinks[h];
            LAS bf16_t* Pw = (LAS bf16_t*)(lds + AT_P_OFF + wave * 16 * AT_PSTR * 2);
            for (int c = lane; c < 256; c += 64) Pw[(c >> 4) * AT_PSTR + 16 + (c & 15)] = 0;
            const bf16_t* qbase = Qb + (size_t)(b * SEQ + nb * 128 + half * 64 + fr) * AW + h * 64 + quad * 8;
            bf16x8 qn0 = *(const bf16x8*)qbase, qn1 = *(const bf16x8*)(qbase + 32);
            for (int rt = 0; rt < 4; ++rt) {
                const int iq0 = half * 64 + rt * 16;
                const bf16x8 qf0 = qn0, qf1 = qn1;
                if (rt < 3) { qn0 = *(const bf16x8*)(qbase + (size_t)(rt + 1) * 16 * AW); qn1 = *(const bf16x8*)(qbase + (size_t)(rt + 1) * 16 * AW + 32); }
                f32x4 s[13];
#define AT_KROW(kt) (((kt) == 0) ? 0 : 32 + 64 * half + ((kt) - 1) * 16)
                bf16x8 kc0 = *(const LAS bf16x8*)(lds + AT_K_OFF + ((AT_KROW(0) + fr) * AT_KSTR + quad * 8) * 2);
                bf16x8 kc1 = *(const LAS bf16x8*)(lds + AT_K_OFF + ((AT_KROW(0) + fr) * AT_KSTR + 32 + quad * 8) * 2);
#pragma unroll
                for (int kt = 0; kt < 13; ++kt) {
                    bf16x8 kn0 = kc0, kn1 = kc1;
                    if (kt < 12) { kn0 = *(const LAS bf16x8*)(lds + AT_K_OFF + ((AT_KROW(kt + 1) + fr) * AT_KSTR + quad * 8) * 2);
                                   kn1 = *(const LAS bf16x8*)(lds + AT_K_OFF + ((AT_KROW(kt + 1) + fr) * AT_KSTR + 32 + quad * 8) * 2); }
                    f32x4 z = {0.f, 0.f, 0.f, 0.f};
                    z = __builtin_amdgcn_mfma_f32_16x16x32_bf16(qf0, kc0, z, 0, 0, 0);
                    s[kt] = __builtin_amdgcn_mfma_f32_16x16x32_bf16(qf1, kc1, z, 0, 0, 0);
                    kc0 = kn0; kc1 = kn1;
                    __builtin_amdgcn_sched_barrier(0);
                }
#undef AT_KROW
                float mx[4] = {sink, sink, sink, sink};
#pragma unroll
                for (int kt = 0; kt < 13; ++kt)
#pragma unroll
                    for (int j = 0; j < 4; ++j) {
                        const int iq = iq0 + quad * 4 + j; float v;
                        if (kt == 0) { int dist = nb * 128 + iq + 16 - fr; dist = dist > 128 ? 128 : dist; v = s[kt][j] * 0.125f + tab[g * 132 + dist]; }
                        else { const int kkr = 64 * half + (kt - 1) * 16 + fr, dist = iq + 128 - kkr;
                            const bool valid = (dist >= 0) && (dist < 128) && (nb > 0 || kkr >= 128);
                            v = valid ? s[kt][j] * 0.125f + tab[g * 132 + (dist & 127)] : -1e30f; }
                        s[kt][j] = v; mx[j] = fmaxf(mx[j], v);
                    }
                float l[4];
#pragma unroll
                for (int j = 0; j < 4; ++j) { mx[j] = row16_max(mx[j]); l[j] = 0.f; }
#pragma unroll
                for (int kt = 0; kt < 13; ++kt) {
                    const int pcol = (kt == 0) ? fr : 32 + (kt - 1) * 16 + fr;
#pragma unroll
                    for (int j = 0; j < 4; ++j) { const float p = __builtin_amdgcn_exp2f((s[kt][j] - mx[j]) * LOG2E); l[j] += p;
                        Pw[(quad * 4 + j) * AT_PSTR + pcol] = (bf16_t)(cvt_pk_bf16(p, p) & 0xffffu); }
                }
#pragma unroll
                for (int j = 0; j < 4; ++j) { l[j] = row16_sum(l[j]) + __builtin_amdgcn_exp2f((sink - mx[j]) * LOG2E); l[j] = 1.0f / l[j]; }
                asm volatile("s_waitcnt lgkmcnt(0)" ::: "memory");
                f32x4 o[4];
#pragma unroll
                for (int dt = 0; dt < 4; ++dt) o[dt] = (f32x4){0.f, 0.f, 0.f, 0.f};
#define AT_CB(ks) (((ks) == 0) ? 0 : 32 + 64 * half + ((ks) - 1) * 32)
                bf16x8 pc = *(const LAS bf16x8*)(Pw + fr * AT_PSTR + quad * 8), vc[4];
#pragma unroll
                for (int dt = 0; dt < 4; ++dt) vc[dt] = *(const LAS bf16x8*)(vt + (dt * 16 + fr) * AT_VSTR + AT_CB(0) + quad * 8);
#pragma unroll
                for (int ks = 0; ks < 7; ++ks) {
                    bf16x8 pn = pc, vn[4];
#pragma unroll
                    for (int dt = 0; dt < 4; ++dt) vn[dt] = vc[dt];
                    if (ks < 6) { pn = *(const LAS bf16x8*)(Pw + fr * AT_PSTR + (ks + 1) * 32 + quad * 8);
#pragma unroll
                        for (int dt = 0; dt < 4; ++dt) vn[dt] = *(const LAS bf16x8*)(vt + (dt * 16 + fr) * AT_VSTR + AT_CB(ks + 1) + quad * 8); }
#pragma unroll
                    for (int dt = 0; dt < 4; ++dt) o[dt] = __builtin_amdgcn_mfma_f32_16x16x32_bf16(pc, vc[dt], o[dt], 0, 0, 0);
                    pc = pn;
#pragma unroll
                    for (int dt = 0; dt < 4; ++dt) vc[dt] = vn[dt];
                    __builtin_amdgcn_sched_barrier(0);
                }
#undef AT_CB
#pragma unroll
                for (int j = 0; j < 4; ++j) { const size_t orow = (size_t)(b * SEQ + nb * 128 + iq0 + quad * 4 + j);
#pragma unroll
                    for (int dt = 0; dt < 4; ++dt) { const float ov = o[dt][j] * l[j]; YA[orow * AW + h * 64 + dt * 16 + fr] = (bf16_t)(cvt_pk_bf16(ov, ov) & 0xffffu); } }
                asm volatile("s_waitcnt lgkmcnt(0)" ::: "memory");
            }
        }
        __syncthreads();
    }
    if (bid < 16 && meta_q && tid < 128) {
        const int h = bid, i = tid >> 3, d8 = tid & 7, kh = h >> 2;
        const float sink = sinks[h];
        const u32x4 qw = *(const u32x4*)(Qb + (size_t)(MSEQ + i) * AW + h * 64 + d8 * 8);
        u32x4 kw[16], vw[16];
#pragma unroll
        for (int m = 0; m < 16; ++m) { kw[m] = *(const u32x4*)(Kb + (size_t)(MSEQ + m) * KVW + kh * 64 + d8 * 8); vw[m] = *(const u32x4*)(Vb + (size_t)(MSEQ + m) * KVW + kh * 64 + d8 * 8); }
        float sc[16]; float mx = sink;
#pragma unroll
        for (int m = 0; m < 16; ++m) { float dot = 0.f;
#pragma unroll
            for (int e = 0; e < 4; ++e) dot += bflo(qw[e]) * bflo(kw[m][e]) + bfhi(qw[e]) * bfhi(kw[m][e]);
            dot += __shfl_xor(dot, 1); dot += __shfl_xor(dot, 2); dot += __shfl_xor(dot, 4);
            const int dist = i - m;
            sc[m] = (dist >= 0) ? dot * 0.125f + rel_bias[(dist < 0 ? 0 : dist) * 16 + h] : -1e30f;
            mx = fmaxf(mx, sc[m]); }
        float l = __builtin_amdgcn_exp2f((sink - mx) * LOG2E); float o[8];
#pragma unroll
        for (int e = 0; e < 8; ++e) o[e] = 0.f;
#pragma unroll
        for (int m = 0; m < 16; ++m) { const float p = __builtin_amdgcn_exp2f((sc[m] - mx) * LOG2E); l += p;
#pragma unroll
            for (int e = 0; e < 4; ++e) { o[2 * e] += p * bflo(vw[m][e]); o[2 * e + 1] += p * bfhi(vw[m][e]); } }
        const float inv = 1.0f / l;
        u32x4 w; w.x = cvt_pk_bf16(o[0] * inv, o[1] * inv); w.y = cvt_pk_bf16(o[2] * inv, o[3] * inv); w.z = cvt_pk_bf16(o[4] * inv, o[5] * inv); w.w = cvt_pk_bf16(o[6] * inv, o[7] * inv);
        *(u32x4*)(YA + (size_t)(MSEQ + i) * AW + h * 64 + d8 * 8) = w;
    }
}

__device__ __forceinline__ void sincos_acc(float x, float& sn, float& cs) {
    const float k = rintf(x * 0.636619772367581f);
    float r = fmaf(-k, 1.5703125f, x); r = fmaf(-k, 4.837512969970703125e-4f, r); r = fmaf(-k, 7.54978995489188216e-8f, r);
    const float r2 = r * r;
    const float sp = r + r * r2 * (-1.6666654611e-1f + r2 * (8.3321608736e-3f + r2 * (-1.9515295891e-4f)));
    const float cp = 1.0f - 0.5f * r2 + r2 * r2 * (4.166664568298827e-2f + r2 * (-1.388731625493765e-3f + r2 * 2.443315711809948e-5f));
    const int q = ((int)k) & 3;
    sn = (q == 0) ? sp : (q == 1) ? cp : (q == 2) ? -sp : -cp;
    cs = (q == 0) ? cp : (q == 1) ? -sp : (q == 2) ? -cp : sp;
}

__device__ __forceinline__ void ssm_tables(const Args& a, f32x2* AR, bf16_t* BB, int tid, int bid) {
    const int gt = bid * 512 + tid;
    if (gt < 2 * 64 * 64) {
        const int l = gt >> 12, g = (gt >> 6) & 63;
        const float lr = a.in[8][gt], li = a.in[9][gt], dt = expf(a.in[10][l * 64 + g]);
        const float decay = expf(lr * dt); float sn, cs; sincos_acc(li * dt, sn, cs);
        const float ar = decay * cs, ai = decay * sn;
        const float den = lr * lr + li * li, nr = ar - 1.0f, ni = ai;
        const float zr = (nr * lr + ni * li) / den, zi = (ni * lr - nr * li) / den;
        AR[gt] = (f32x2){ar, ai};
        const float* br = a.in[11] + (size_t)gt * 16; const float* bi = a.in[12] + (size_t)gt * 16;
        u32x4 wre[2], wim[2];
#pragma unroll
        for (int h = 0; h < 2; ++h) {
            float re[8], im[8];
#pragma unroll
            for (int e = 0; e < 8; ++e) { const float x = br[h * 8 + e], y = bi[h * 8 + e]; re[e] = zr * x - zi * y; im[e] = zr * y + zi * x; }
            wre[h] = (u32x4){cvt_pk_bf16(re[0], re[1]), cvt_pk_bf16(re[2], re[3]), cvt_pk_bf16(re[4], re[5]), cvt_pk_bf16(re[6], re[7])};
            wim[h] = (u32x4){cvt_pk_bf16(im[0], im[1]), cvt_pk_bf16(im[2], im[3]), cvt_pk_bf16(im[4], im[5]), cvt_pk_bf16(im[6], im[7])};
        }
        u32x4* o = (u32x4*)(BB + (size_t)gt * 32);
        o[0] = wre[0]; o[1] = wre[1]; o[2] = wim[0]; o[3] = wim[1];
    }
}

constexpr int SSM_XSTR = 132, SSM_WBYTES = 16 * SSM_XSTR * 4 + 16 * 272;
static_assert(8 * SSM_WBYTES <= LDS_BYTES, "ssm lds");
template <int PASS>
__device__ __forceinline__ void ssm_phase(const Args& a, int l, const bf16_t* U, bf16_t* Y, f32x2* SC, const f32x2* AR, const bf16_t* BB, LAS unsigned char* lds, int wave, int lane, int bid,
                                          const float* __restrict__ cvW = nullptr, bf16_t* __restrict__ cvWt = nullptr, int cvK = 64, int cvN = 64) {
    const float* c_re = a.in[13] + (size_t)l * 65536; const float* c_im = a.in[14] + (size_t)l * 65536; const float* dsk = a.in[15] + l * 1024;
    constexpr int NCH = (PASS == 1) ? 31 : 32;
    const int fr = lane & 15, quad = lane >> 4;
    LAS unsigned char* Xw = lds + wave * SSM_WBYTES;
    LAS unsigned char* Hw = Xw + 16 * SSM_XSTR * 4;
    int gprev = -1; float ar = 0.f, ai = 0.f, dskp = 0.f; bf16x8 bfA[8], cf[4];
#pragma unroll
    for (int i = 0; i < 8; ++i) bfA[i] = (bf16x8){0, 0, 0, 0, 0, 0, 0, 0};
#pragma unroll
    for (int i = 0; i < 4; ++i) cf[i] = (bf16x8){0, 0, 0, 0, 0, 0, 0, 0};
    int ct = bid * 8 + wave; const int cstride = gridDim.x * 8, ctn = cvN / 64, cntile = (PASS == 2 && cvW) ? ctn * (cvK / 64) : 0;
    for (int id = bid * 8 + wave; id < NB * 64 * NCH; id += gridDim.x * 8) {
        const int g = id & 63, c = (id >> 6) % NCH, b = id / (64 * NCH);
        float cf32[64]; const bool chave = (PASS == 2) && (ct < cntile); const int ck0 = (ct / ctn) * 64, cn0 = (ct % ctn) * 64;
        if (PASS == 2) {
            if (chave) { const float* csrc = cvW + (size_t)ck0 * cvN + cn0 + lane;
#pragma unroll
                for (int e = 0; e < 64; ++e) cf32[e] = csrc[(size_t)e * cvN]; }
            else {
#pragma unroll
                for (int e = 0; e < 64; ++e) cf32[e] = 0.f; }
        }
        if (g != gprev) {
            gprev = g;
            const f32x2 aa = AR[(l * 64 + g) * 64 + lane]; ar = aa.x; ai = aa.y;
#pragma unroll
            for (int mt = 0; mt < 8; ++mt) { u32x4 w = {0u, 0u, 0u, 0u}; if (quad < 2) w = *(const u32x4*)(BB + ((size_t)(l * 64 + g) * 128 + mt * 16 + fr) * 16 + quad * 8); bfA[mt] = __builtin_bit_cast(bf16x8, w); }
            if (PASS == 2) {
#pragma unroll
                for (int ks = 0; ks < 4; ++ks) { const f32x4 cr = *(const f32x4*)(c_re + (size_t)(g * 16 + fr) * 64 + ks * 16 + quad * 4), ci = *(const f32x4*)(c_im + (size_t)(g * 16 + fr) * 64 + ks * 16 + quad * 4);
                    u32x4 w; w.x = cvt_pk_bf16(cr[0], -ci[0]); w.y = cvt_pk_bf16(cr[1], -ci[1]); w.z = cvt_pk_bf16(cr[2], -ci[2]); w.w = cvt_pk_bf16(cr[3], -ci[3]);
                    cf[ks] = __builtin_bit_cast(bf16x8, w); }
                dskp = dsk[g * 16 + fr];
            }
        }
        float hr = 0.f, hi = 0.f;
        if (PASS == 2 && c > 0) {
            float pr = ar, pi = ai;
#pragma unroll
            for (int q = 0; q < 7; ++q) { const float t = pr * pr - pi * pi; pi = 2.0f * pr * pi; pr = t; }
            const f32x2* sc = SC + ((size_t)(b * 64 + g) * 32) * 64 + lane;
            const f32x2 s0 = sc[0]; hr = s0.x; hi = s0.y;
            f32x2 sv[31];
#pragma unroll
            for (int j = 0; j < 31; ++j) sv[j] = (j + 1 < c) ? sc[(j + 1) * 64] : (f32x2){0.f, 0.f};
#pragma unroll
            for (int j = 0; j < 31; ++j) if (j + 1 < c) { const float t = pr * hr - pi * hi + sv[j].x; hi = pr * hi + pi * hr + sv[j].y; hr = t; }
        }
        const int nblk = (c == 0) ? 9 : 8;
#define SSM_ROWBASE(k) ((c == 0) ? ((k) == 0 ? MSEQ : b * SEQ + ((k) - 1) * 16) : b * SEQ + c * 128 + (k) * 16)
#define SSM_LOADU(k) ((quad < 2) ? *(const u32x4*)(U + (size_t)(SSM_ROWBASE(k) + fr) * SW + g * 16 + quad * 8) : (u32x4){0u, 0u, 0u, 0u})
        u32x4 v1 = SSM_LOADU(0);
        {   const bf16x8 uf0 = __builtin_bit_cast(bf16x8, v1);
#pragma unroll
            for (int mt = 0; mt < 8; ++mt) { const f32x4 x = __builtin_amdgcn_mfma_f32_16x16x32_bf16(bfA[mt], uf0, (f32x4){0.f, 0.f, 0.f, 0.f}, 0, 0, 0);
                *(LAS f32x4*)(Xw + (fr * SSM_XSTR + mt * 16 + quad * 4) * 4) = x; } }
        if (nblk > 1) v1 = SSM_LOADU(1);
        for (int k = 0; k < nblk; ++k) {
            const int rb = SSM_ROWBASE(k);
            u32x4 v2 = v1;
            if (k + 2 < nblk) v2 = SSM_LOADU(k + 2);
            bf16_t usk[4] = {0, 0, 0, 0};
            if (PASS == 2) {
#pragma unroll
                for (int j = 0; j < 4; ++j) usk[j] = U[(size_t)(rb + quad * 4 + j) * SW + g * 16 + fr]; }
            asm volatile("s_waitcnt lgkmcnt(0)" ::: "memory");
            f32x2 xx[16];
#pragma unroll
            for (int tt = 0; tt < 16; ++tt) xx[tt] = *(const LAS f32x2*)(Xw + (tt * SSM_XSTR + 2 * lane) * 4);
            asm volatile("s_waitcnt lgkmcnt(0)" ::: "memory");
            if (k + 1 < nblk) { const bf16x8 uf1 = __builtin_bit_cast(bf16x8, v1);
#pragma unroll
                for (int mt = 0; mt < 8; ++mt) { const f32x4 x = __builtin_amdgcn_mfma_f32_16x16x32_bf16(bfA[mt], uf1, (f32x4){0.f, 0.f, 0.f, 0.f}, 0, 0, 0);
                    *(LAS f32x4*)(Xw + (fr * SSM_XSTR + mt * 16 + quad * 4) * 4) = x; } }
#pragma unroll
            for (int tt = 0; tt < 16; ++tt) {
                const float nhr = fmaf(ar, hr, fmaf(-ai, hi, xx[tt].x)), nhi = fmaf(ar, hi, fmaf(ai, hr, xx[tt].y));
                hr = nhr; hi = nhi;
                if (PASS == 2) *(LAS unsigned*)(Hw + tt * 272 + lane * 4) = cvt_pk_bf16(hr, hi);
            }
            if (PASS == 2) {
                const bool wr_ok = (rb < MSEQ) || (b == 0);
                asm volatile("s_waitcnt lgkmcnt(0)" ::: "memory");
                f32x4 acc = {0.f, 0.f, 0.f, 0.f};
#pragma unroll
                for (int ks = 0; ks < 4; ++ks) { const bf16x8 af = *(const LAS bf16x8*)(Hw + fr * 272 + ks * 64 + quad * 16); acc = __builtin_amdgcn_mfma_f32_16x16x32_bf16(af, cf[ks], acc, 0, 0, 0); }
#pragma unroll
                for (int j = 0; j < 4; ++j) { const size_t row = (size_t)(rb + quad * 4 + j);
                    const float uu = bf2f(usk[j]);
                    const float y = acc[j] + dskp * uu;
                    const float z2 = 1.5957691216f * (y + 0.044715f * y * y * y);
                    const float gy = y * __builtin_amdgcn_rcpf(1.0f + __builtin_amdgcn_exp2f(-z2 * LOG2E));
                    if (wr_ok) Y[row * SW + g * 16 + fr] = (bf16_t)(cvt_pk_bf16(gy, gy) & 0xffffu); }
            }
            asm volatile("s_waitcnt lgkmcnt(0)" ::: "memory");
            v1 = v2;
        }
#undef SSM_ROWBASE
#undef SSM_LOADU
        if (PASS == 1) SC[((size_t)(b * 64 + g) * 32 + c) * 64 + lane] = (f32x2){hr, hi};
        if (PASS == 2) {
            if (chave) { bf16_t* cdst = cvWt + (size_t)(cn0 + lane) * cvK + ck0;
#pragma unroll
                for (int kg = 0; kg < 8; ++kg) { u32x4 w; w.x = cvt_pk_bf16(cf32[kg * 8 + 0], cf32[kg * 8 + 1]); w.y = cvt_pk_bf16(cf32[kg * 8 + 2], cf32[kg * 8 + 3]); w.z = cvt_pk_bf16(cf32[kg * 8 + 4], cf32[kg * 8 + 5]); w.w = cvt_pk_bf16(cf32[kg * 8 + 6], cf32[kg * 8 + 7]);
                    *(u32x4*)(cdst + kg * 8) = w; } }
            ct += cstride;
        }
    }
    if (PASS == 2 && cvW) {
        for (; ct < cntile; ct += cstride) { const int k0 = (ct / ctn) * 64, n0 = (ct % ctn) * 64; const float* src = cvW + (size_t)k0 * cvN + n0 + lane; float f[64];
#pragma unroll
            for (int e = 0; e < 64; ++e) f[e] = src[(size_t)e * cvN];
            bf16_t* dst = cvWt + (size_t)(n0 + lane) * cvK + k0;
#pragma unroll
            for (int kg = 0; kg < 8; ++kg) { u32x4 w; w.x = cvt_pk_bf16(f[kg * 8 + 0], f[kg * 8 + 1]); w.y = cvt_pk_bf16(f[kg * 8 + 2], f[kg * 8 + 3]); w.z = cvt_pk_bf16(f[kg * 8 + 4], f[kg * 8 + 5]); w.w = cvt_pk_bf16(f[kg * 8 + 6], f[kg * 8 + 7]);
                *(u32x4*)(dst + kg * 8) = w; } }
    }
}

__device__ __forceinline__ void skinny_gemm(const pg8::Gemm& g, const pg8::EpiAll& E, LAS unsigned char* lds, int tid, int wave, int lane, int bid) {
    const int fr = lane & 15, quad = lane >> 4, K = g.K, kw = K >> 3;
    LAS f32x4* red = (LAS f32x4*)lds;
    for (int task = bid; task < (g.N >> 4); task += gridDim.x) {
        const int n0 = task << 4;
        const bf16_t* ap = g.A + (size_t)(MSEQ + fr) * K + wave * kw + quad * 8;
        const bf16_t* bp = g.Bt + (size_t)(n0 + fr) * K + wave * kw + quad * 8;
        f32x4 acc = {0.f, 0.f, 0.f, 0.f};
        for (int k = 0; k < kw; k += 256) {
            bf16x8 af[8], bf[8];
#pragma unroll
            for (int i = 0; i < 8; ++i) { af[i] = (bf16x8){0, 0, 0, 0, 0, 0, 0, 0}; bf[i] = af[i]; if (k + i * 32 < kw) { af[i] = *(const bf16x8*)(ap + k + i * 32); bf[i] = *(const bf16x8*)(bp + k + i * 32); } }
#pragma unroll
            for (int i = 0; i < 8; ++i) acc = __builtin_amdgcn_mfma_f32_16x16x32_bf16(af[i], bf[i], acc, 0, 0, 0);
        }
        red[wave * 64 + lane] = acc;
        __syncthreads();
        if (wave == 0) {
            f32x4 s = red[lane];
#pragma unroll
            for (int w = 1; w < 8; ++w) s = s + red[w * 64 + lane];
            const int col = n0 + fr;
            bf16_t xpre[4] = {0, 0, 0, 0}, opre[4] = {0, 0, 0, 0};
#pragma unroll
            for (int j = 0; j < 4; ++j) { const size_t row = (size_t)(MSEQ + quad * 4 + j);
                if (E.mode == 5) xpre[j] = E.X[row * D + col];
                else if (E.mode >= 1 && E.mode <= 3) { xpre[j] = E.X[row * E.ldx + col]; if (E.mode == 3) opre[j] = E.O[row * E.ldc + col]; } }
            asm volatile("" ::: "memory");
#pragma unroll
            for (int j = 0; j < 4; ++j) {
                const size_t row = (size_t)(MSEQ + quad * 4 + j); float v = s[j];
                if (E.mode == 5) { const float rr = bf2f(xpre[j]) * DN_ALPHA + v; if (E.H) E.H[row * D + col] = rr; else E.O[row * D + col] = (bf16_t)(cvt_pk_bf16(rr, rr) & 0xffffu); }
                else {
                    bf16_t* op;
                    if (E.mode == 0) {
                        if (col < 1024) op = E.Q + row * AW + col;
                        else if (col < 1280) op = E.Kb + row * KVW + (col - 1024);
                        else if (col < 1536) op = E.Vb + row * KVW + (col - 1280);
                        else if (col < 2560) op = E.U + row * SW + (col - 1536);
                        else { op = E.G + row * 4096 + (col - 2560); v = sigmoid_f(v + E.gb[col - 2560]); }
                    } else {
                        op = E.O + row * E.ldc + col;
                        if (E.mode == 4) { v = fmaxf(v, 0.f); v = v * v; }
                        else { const float x = bf2f(xpre[j]);
                            if (E.mode == 1) v = x * sigmoid_f(v); else { v = v * x; if (E.mode == 3) v += bf2f(opre[j]); } }
                    }
                    *op = (bf16_t)(cvt_pk_bf16(v, v) & 0xffffu);
                }
            }
        }
        __syncthreads();
    }
}

__device__ __forceinline__ void fast_grid_barrier(unsigned* bar, unsigned gen, unsigned nblk) {
    asm volatile("s_waitcnt vmcnt(0) lgkmcnt(0)" ::: "memory");
    __syncthreads();
    if (threadIdx.x == 0) {
        __builtin_amdgcn_fence(__ATOMIC_RELEASE, "agent");
        asm volatile("s_waitcnt vmcnt(0)" ::: "memory");
        const unsigned old = __hip_atomic_fetch_add(bar, 1u, __ATOMIC_RELAXED, __HIP_MEMORY_SCOPE_AGENT);
        if (old == gen * nblk - 1u) {
            __builtin_amdgcn_fence(__ATOMIC_ACQUIRE, "agent");
            __hip_atomic_store(bar + 64, gen, __ATOMIC_RELEASE, __HIP_MEMORY_SCOPE_AGENT);
        } else {
            while (__hip_atomic_load(bar + 64, __ATOMIC_RELAXED, __HIP_MEMORY_SCOPE_AGENT) < gen) __builtin_amdgcn_s_sleep(1);
        }
        __builtin_amdgcn_fence(__ATOMIC_ACQUIRE, "agent");
        asm volatile("s_waitcnt vmcnt(0)" ::: "memory");
    }
    __syncthreads();
}

constexpr int NPHASE = 1 + 2 * 11;
__global__ void __launch_bounds__(512, 2) fwd_kernel(Args a) {
    extern __shared__ __attribute__((aligned(16))) unsigned char lds_raw[];
    LAS unsigned char* lds = (LAS unsigned char*)lds_raw;
    cg::grid_group grid = cg::this_grid();
    unsigned bgen = 0;
    for (int ph = a.ph_lo; ph < a.ph_hi; ++ph) {
#if PROBE_MASK
        const unsigned long long t_ph0 = __builtin_amdgcn_s_memrealtime();
#endif
        int tid = threadIdx.x, bid = blockIdx.x;
        asm volatile("" : "+v"(tid)); asm volatile("" : "+s"(bid));
        const int lane = tid & 63, wave = __builtin_amdgcn_readfirstlane(tid >> 6);
        unsigned char* ws = a.ws;
        float* H32 = (float*)(ws + OFF_H32);
        bf16_t* HB = (bf16_t*)(ws + OFF_HB);
        unsigned char* pool = ws + OFF_POOL;
        bf16_t* Qb = (bf16_t*)(pool + PO_Q); bf16_t* Kb = (bf16_t*)(pool + PO_K); bf16_t* Vb = (bf16_t*)(pool + PO_V); bf16_t* Ub = (bf16_t*)(pool + PO_U);
        bf16_t* Gb = (bf16_t*)(pool + PO_G); bf16_t* YA = (bf16_t*)(pool + PO_YA);
        bf16_t* YS = (bf16_t*)H32;
        bf16_t* MP = (bf16_t*)H32;
        float* RMIX = (float*)(pool + PO_G);
        bf16_t* YG = Ub;
        bf16_t* F1 = (bf16_t*)pool;
        unsigned char* wt = ws + OFF_WT;
        f32x2* SC = (f32x2*)(ws + OFF_SC); f32x2* AR = (f32x2*)(ws + OFF_AR); bf16_t* BB = (bf16_t*)(ws + OFF_BB);
        const int l = (ph - 1) / 11, kind = (ph == 0) ? -1 : (ph - 1) % 11;
        bool is_gemm = false; pg8::Gemm g{nullptr, nullptr, MPAD, 0, 0}; pg8::EpiAll E{};
        if (kind == 0 && EN(0)) { is_gemm = true; g = pg8::Gemm{HB, (const bf16_t*)(wt + WA_IN), MPAD, INW, D};
            E.mode = 0; E.Q = Qb; E.Kb = Kb; E.Vb = Vb; E.U = Ub; E.G = Gb; E.gb = a.in[6] + (size_t)l * 4096; }
        else if (kind == 3 && EN(3)) { is_gemm = true; g = pg8::Gemm{YS, (const bf16_t*)(wt + WA_GLU), MPAD, SW, SW}; E.mode = 1; E.O = YG; E.ldc = SW; E.X = YS; E.ldx = SW; }
        else if (kind == 4 && EN(4)) { is_gemm = true; g = pg8::Gemm{YA, (const bf16_t*)(wt + WA_AU), MPAD, D, AW}; E.mode = 2; E.O = MP; E.ldc = D; E.X = Gb; E.ldx = 4096; }
        else if (kind == 5 && EN(4)) { is_gemm = true; g = pg8::Gemm{YG, (const bf16_t*)(wt + WA_SU), MPAD, D, SW}; E.mode = 3; E.O = MP; E.ldc = D; E.X = Gb + 2048; E.ldx = 4096; }
        else if (kind == 6 && EN(5)) { is_gemm = true; g = pg8::Gemm{MP, (const bf16_t*)(wt + WA_OUT), MPAD, D, D}; E.mode = 5; E.O = (bf16_t*)RMIX; E.X = HB; }
        else if (kind == 8 && EN(7)) { is_gemm = true; g = pg8::Gemm{HB, (const bf16_t*)(wt + WB_UP), MPAD, DFF, D}; E.mode = 4; E.O = F1; E.ldc = DFF; }
        else if (kind == 9 && EN(8)) { is_gemm = true; g = pg8::Gemm{F1, (const bf16_t*)(wt + WB_DN), MPAD, D, DFF}; E.mode = 5; E.X = HB; if (l == 1) E.H = H32; else E.O = (bf16_t*)H32; }
        if (is_gemm) {
            pg8::StaticOrder S; S.init(MSEQ, g.N, (int)gridDim.x, bid, kind == 9);
            pg8::gemm_phase(lds, g, S, E, tid);
            if (kind == 0) {
                const int nwg = (MSEQ / 256) * (INW / 256), rem = nwg % (int)gridDim.x;
                if (rem != 0 && bid >= rem) convert_mlp_down(a, l, wt, wave, lane, bid - rem, (int)gridDim.x - rem);
                else if (rem == 0) convert_mlp_down(a, l, wt, wave, lane, bid, (int)gridDim.x);
            }
            if (l == 0 || kind == 0) skinny_gemm(g, E, lds, tid, wave, lane, bid);
        } else if (ph == 0 && EN(10)) {
            ssm_tables(a, AR, BB, tid, bid);
            ln_phase<0>(a.in[0], a.in[1], a.in[2], a.in[3], H32, HB, nullptr, wave, lane, bid);
            convert_group_a(a, 0, wt, wave, lane, bid);
        } else if (kind == 1 && EN(1)) {
            attn_phase(Qb, Kb, Vb, YA, a.in[4], a.in[7] + l * 16, lds, tid, wave, lane, bid, l == 0);
            ssm_phase<1>(a, l, Ub, YS, SC, AR, BB, lds, wave, lane, bid);
        } else if (kind == 2 && EN(2)) {
            ssm_phase<2>(a, l, Ub, YS, SC, AR, BB, lds, wave, lane, bid, a.in[22] + (size_t)l * D * DFF, (bf16_t*)(wt + WB_UP), D, DFF);
        } else if (kind == 7 && EN(6)) {
            ln_phase<1>(nullptr, nullptr, a.in[20] + l * D, a.in[21] + l * D, RMIX, HB, nullptr, wave, lane, bid);
        } else if (kind == 10 && EN(9)) {
            if (l == 0) { ln_phase<1>(nullptr, nullptr, a.in[24], a.in[25], H32, HB, nullptr, wave, lane, bid); convert_group_a(a, 1, wt, wave, lane, bid); }
            else ln_phase<2>(nullptr, nullptr, a.in[24] + D, a.in[25] + D, H32, HB, a.out, wave, lane, bid);
        }
        if (ph + 1 < a.ph_hi && kind != 4) {
            if (ph == 0) grid.sync();
            else fast_grid_barrier((unsigned*)(a.ws + OFF_BAR), ++bgen, gridDim.x);
        }
#if PROBE_MASK
        if ((PROBE_MASK >> (kind + 1)) & 1) {
            const unsigned long long t1 = __builtin_amdgcn_s_memrealtime();
            while (__builtin_amdgcn_s_memrealtime() - t1 < (t1 - t_ph0)) __builtin_amdgcn_s_sleep(8);
        }
#endif
    }
}

extern "C" void kernel_launch(void* const* d_in, const int* in_sizes, int n_in, void* d_out, int out_size, void* d_ws, size_t ws_size, hipStream_t stream) {
    static int grid = 0;
    if (grid == 0) {
        if (n_in != 26 || ws_size < WS_END) { fprintf(stderr, "kernel_launch: need 26 inputs and %zu bytes of workspace (got %d, %zu)\n", (size_t)WS_END, n_in, ws_size); grid = -1; return; }
        int dev = 0, cus = 0, per_cu = 0;
        (void)hipGetDevice(&dev);
        (void)hipDeviceGetAttribute(&cus, hipDeviceAttributeMultiprocessorCount, dev);
        if (hipFuncSetAttribute((const void*)fwd_kernel, hipFuncAttributeMaxDynamicSharedMemorySize, LDS_BYTES) != hipSuccess) { fprintf(stderr, "kernel_launch: hipFuncSetAttribute failed\n"); grid = -1; return; }
        if (hipOccupancyMaxActiveBlocksPerMultiprocessor(&per_cu, (const void*)fwd_kernel, 512, LDS_BYTES) != hipSuccess || per_cu < 1) { fprintf(stderr, "kernel_launch: occupancy query says %d\n", per_cu); per_cu = 1; }
        (void)hipGetLastError();
        grid = cus;
    }
    if (grid < 0) return;
    Args a{};
    for (int i = 0; i < 26; ++i) a.in[i] = (const float*)d_in[i];
    a.out = (float*)d_out; a.ws = (unsigned char*)d_ws; a.ph_lo = 0; a.ph_hi = NPHASE;
    (void)hipMemsetAsync((unsigned char*)d_ws + OFF_BAR, 0, SZ_BAR, stream);
    void* args[] = {&a};
    hipError_t e = hipLaunchCooperativeKernel((const void*)fwd_kernel, dim3(grid), dim3(512), args, LDS_BYTES, stream);
    if (e != hipSuccess) fprintf(stderr, "kernel_launch: cooperative launch failed: %s (grid %d)\n", hipGetErrorString(e), grid);
}
```
